# Optimizing an MI355X kernel written in HIP

```python
import math
import jax, jax.numpy as jnp
from jax import lax
import numpy as np

D_MODEL = 1024
BATCH = 16
SEQ = 2048
DEPTH = 4
DEC_BATCH = 32
DEC_SEQ = 64
PAST_LEN = 1024

CHUNK = 64
D_MIX = D_MODEL
D_RET = D_MIX // 2
D_SSM = D_MIX // 4
D_LRU = D_MIX - D_RET - D_SSM
RET_HEADS = 4
RET_HEAD_DIM = D_RET // RET_HEADS
ROPE_BASE = 10000.0
SSM_GROUP = 16
SSM_GROUPS = D_SSM // SSM_GROUP
SSM_STATE = 64
LRU_BLOCKS = 4
LRU_BLOCK = D_LRU // LRU_BLOCKS
CONV_W = 4
LRU_C = 8.0
D_FFN = ((8 * D_MODEL // 3 + 255) // 256) * 256
D_IN = 4 * D_RET + D_SSM + 2 * D_LRU
_SPLITS = (D_RET, 2 * D_RET, 3 * D_RET, 4 * D_RET, 4 * D_RET + D_SSM, 4 * D_RET + D_SSM + D_LRU)
EPS = 1e-6
GN_EPS = 1e-5

kernel_name = "hybrid_retention_s5_rglru_stream_step"


def _rmsnorm(x, g):
    xf = x.astype(jnp.float32)
    y = xf * lax.rsqrt(jnp.mean(xf * xf, axis=-1, keepdims=True) + EPS)
    return (y * g.astype(jnp.float32)).astype(x.dtype)


def _rms(x):
    return x * lax.rsqrt(jnp.mean(x * x, axis=-1, keepdims=True) + EPS)


def _group_norm(o):
    mu = jnp.mean(o, axis=-1, keepdims=True)
    oc = o - mu
    return oc * lax.rsqrt(jnp.mean(oc * oc, axis=-1, keepdims=True) + GN_EPS)


def _rotary(x, pos):
    d = x.shape[-1]
    inv_freq = ROPE_BASE ** (-jnp.arange(0, d, 2, dtype=jnp.float32) / d)
    ang = pos.astype(jnp.float32)[:, None] * inv_freq[None, :]
    cos = jnp.cos(ang)[None, :, None, :]
    sin = jnp.sin(ang)[None, :, None, :]
    x1, x2 = x[..., : d // 2], x[..., d // 2:]
    return jnp.concatenate([x1 * cos - x2 * sin, x2 * cos + x1 * sin], axis=-1)


def _linear_scan(a, b):
    def comb(e1, e2):
        a1, b1 = e1
        a2, b2 = e2
        return a1 * a2, a2 * b1 + b2
    _, h = lax.associative_scan(comb, (a, b), axis=1)
    return h


def _retention(q, k, v, s0):
    b, l, h, d = q.shape
    cs = min(CHUNK, l)
    nc = l // cs
    gamma = 1.0 - 2.0 ** (-5.0 - jnp.arange(h, dtype=jnp.float32))
    log_g = jnp.log(gamma)
    idx = jnp.arange(cs, dtype=jnp.float32)
    intra = jnp.exp(log_g[:, None, None] * jnp.abs(idx[:, None] - idx[None, :]))
    q = q.reshape(b, nc, cs, h, d)
    k = k.reshape(b, nc, cs, h, d)
    v = v.reshape(b, nc, cs, h, d)
    scores = jnp.einsum('bnihd,bnjhd->bnhij', q, k) * intra
    o_intra = jnp.einsum('bnhij,bnjhd->bnihd', scores, v)
    k_dec = jnp.exp(log_g[None, :] * (cs - 1.0 - idx)[:, None])
    u = jnp.einsum('bnjhk,bnjhv,jh->nbhkv', k, v, k_dec)
    g_chunk = jnp.exp(log_g * cs)[:, None, None]

    def step(s, u_c):
        return g_chunk * s + u_c, s

    s_final, s_prev = lax.scan(step, s0, u)
    q_dec = jnp.exp(log_g[None, :] * (idx + 1.0)[:, None])
    o_cross = jnp.einsum('bnihk,nbhkv,ih->bnihv', q, s_prev, q_dec)
    return (o_intra + o_cross).reshape(b, l, h, d), s_final


def _s5(u, h0, a_re, a_im, b_re, b_im, c_re, c_im, d_skip, log_dt, w_glu):
    bsz, l, _ = u.shape
    uf = u.reshape(bsz, l, SSM_GROUPS, SSM_GROUP)
    lam = lax.complex(a_re.astype(jnp.float32), a_im.astype(jnp.float32))
    dt = jnp.exp(log_dt.astype(jnp.float32))[:, None]
    lam_bar = jnp.exp(lam * dt)
    bmat = lax.complex(b_re.astype(jnp.float32), b_im.astype(jnp.float32))
    b_bar = ((lam_bar - 1.0) / lam)[..., None] * bmat
    bu = jnp.einsum('blgc,gpc->blgp', uf, b_bar)
    bu = bu.at[:, 0].add(lam_bar[None] * h0)
    h = _linear_scan(jnp.broadcast_to(lam_bar, bu.shape), bu)
    cmat = lax.complex(c_re.astype(jnp.float32), c_im.astype(jnp.float32))
    y = jnp.einsum('blgp,gcp->blgc', h, cmat).real + d_skip.astype(jnp.float32).reshape(SSM_GROUPS, SSM_GROUP) * uf
    y = jax.nn.gelu(y.reshape(bsz, l, D_SSM))
    ga = jnp.matmul(y, w_glu.astype(jnp.float32))
    return ga[..., :D_SSM] * jax.nn.sigmoid(ga[..., D_SSM:]), h[:, -1]


def _rglru(x_in, gate, conv_buf, h0, conv_w, conv_b, w_a, b_a, w_x, b_x, lam):
    bsz, l, _ = x_in.shape
    padded = jnp.concatenate([conv_buf.astype(jnp.float32), x_in], axis=1)
    cw = conv_w.astype(jnp.float32)
    xc = conv_b.astype(jnp.float32) + sum(padded[:, t:t + l] * cw[t] for t in range(CONV_W))
    new_buf = padded[:, -(CONV_W - 1):]
    xb = xc.reshape(bsz, l, LRU_BLOCKS, LRU_BLOCK)
    r = jax.nn.sigmoid(jnp.einsum('blhi,hij->blhj', xb, w_a.astype(jnp.float32)).reshape(bsz, l, D_LRU) + b_a.astype(jnp.float32))
    ig = jax.nn.sigmoid(jnp.einsum('blhi,hij->blhj', xb, w_x.astype(jnp.float32)).reshape(bsz, l, D_LRU) + b_x.astype(jnp.float32))
    log_a = -LRU_C * r * jax.nn.softplus(-lam.astype(jnp.float32))
    a = jnp.exp(log_a)
    bx = jnp.sqrt(-jnp.expm1(2.0 * log_a)) * (ig * xc)
    bx = bx.at[:, 0].add(a[:, 0] * h0.astype(jnp.float32))
    h = _linear_scan(a, bx)
    return h * jax.nn.gelu(gate), h[:, -1], new_buf


def _trunk(x, pos_offset, s_ret, s_ssm, s_lru, c_conv, p):
    b, l, _ = x.shape
    pos = pos_offset + jnp.arange(l, dtype=jnp.int32)
    new_ret, new_ssm, new_lru, new_conv = [], [], [], []
    for i in range(DEPTH):
        h = _rmsnorm(x, p['norm_mix'][i])
        proj = jnp.matmul(h, p['w_in'][i]).astype(jnp.float32)
        q, k, v, g, u_ssm, x_lru, gate_lru = jnp.split(proj, _SPLITS, axis=-1)
        qh = _rotary(q.reshape(b, l, RET_HEADS, RET_HEAD_DIM), pos) * (RET_HEAD_DIM ** -0.5)
        kh = _rotary(k.reshape(b, l, RET_HEADS, RET_HEAD_DIM), pos)
        vh = v.reshape(b, l, RET_HEADS, RET_HEAD_DIM)
        o_ret, sr = _retention(qh, kh, vh, s_ret[i].astype(jnp.float32))
        o_ret = _group_norm(o_ret).reshape(b, l, D_RET) * jax.nn.silu(g)
        st = s_ssm[i].astype(jnp.float32)
        h0 = lax.complex(st[..., 0], st[..., 1])
        o_ssm, hs = _s5(u_ssm, h0, p['ssm_a_re'][i], p['ssm_a_im'][i], p['ssm_b_re'][i], p['ssm_b_im'][i],
                        p['ssm_c_re'][i], p['ssm_c_im'][i], p['ssm_d'][i], p['ssm_log_dt'][i], p['ssm_w_glu'][i])
        o_lru, hl, cb = _rglru(x_lru, gate_lru, c_conv[i], s_lru[i], p['lru_conv_w'][i], p['lru_conv_b'][i],
                               p['lru_w_a'][i], p['lru_b_a'][i], p['lru_w_x'][i], p['lru_b_x'][i], p['lru_lambda'][i])
        mixed = jnp.concatenate([_rms(o_ret), _rms(o_ssm), _rms(o_lru)], axis=-1) * p['mix_scale'][i].astype(jnp.float32)
        x = x + jnp.matmul(mixed, p['w_out'][i].astype(jnp.float32)).astype(x.dtype)
        h = _rmsnorm(x, p['norm_ffn'][i])
        ff = jax.nn.silu(jnp.matmul(h, p['w_ffn_gate'][i])) * jnp.matmul(h, p['w_ffn_up'][i])
        x = x + jnp.matmul(ff, p['w_ffn_down'][i]).astype(x.dtype)
        new_ret.append(sr)
        new_ssm.append(jnp.stack([hs.real, hs.imag], axis=-1))
        new_lru.append(hl)
        new_conv.append(cb)
    y = _rmsnorm(x, p['norm_final'])
    return y, jnp.stack(new_ret), jnp.stack(new_ssm), jnp.stack(new_lru), jnp.stack(new_conv)


def setup_inputs(seed: int = 0) -> dict:
    key = jax.random.key(seed)
    ks = jax.random.split(key, 32)
    f32 = jnp.float32

    def nrm(k, shape, scale):
        return jax.random.normal(k, shape, f32) * scale

    n_idx = jnp.arange(SSM_STATE, dtype=f32)
    a_target = jax.random.uniform(ks[26], (DEPTH, D_LRU), f32, 0.9, 0.999)
    sig = a_target ** (1.0 / LRU_C)
    return {
        'x_prompt': nrm(ks[0], (BATCH, SEQ, D_MODEL), 1.0),
        'x_sample': nrm(ks[1], (DEC_BATCH, DEC_SEQ, D_MODEL), 1.0),
        'state_ret': nrm(ks[2], (DEPTH, DEC_BATCH, RET_HEADS, RET_HEAD_DIM, RET_HEAD_DIM), 0.5),
        'state_ssm': nrm(ks[3], (DEPTH, DEC_BATCH, SSM_GROUPS, SSM_STATE, 2), 0.5),
        'state_lru': nrm(ks[4], (DEPTH, DEC_BATCH, D_LRU), 0.5),
        'cache_conv': nrm(ks[5], (DEPTH, DEC_BATCH, CONV_W - 1, D_LRU), 1.0),
        'norm_mix': 1.0 + nrm(ks[6], (DEPTH, D_MODEL), 0.01),
        'w_in': nrm(ks[7], (DEPTH, D_MODEL, D_IN), D_MODEL ** -0.5),
        'mix_scale': 1.0 + nrm(ks[8], (DEPTH, D_MIX), 0.01),
        'w_out': nrm(ks[9], (DEPTH, D_MIX, D_MODEL), D_MIX ** -0.5),
        'ssm_a_re': -0.5 + nrm(ks[10], (DEPTH, SSM_GROUPS, SSM_STATE), 0.01),
        'ssm_a_im': math.pi * n_idx + nrm(ks[11], (DEPTH, SSM_GROUPS, SSM_STATE), 0.01),
        'ssm_b_re': nrm(ks[12], (DEPTH, SSM_GROUPS, SSM_STATE, SSM_GROUP), (2.0 * SSM_GROUP) ** -0.5),
        'ssm_b_im': nrm(ks[13], (DEPTH, SSM_GROUPS, SSM_STATE, SSM_GROUP), (2.0 * SSM_GROUP) ** -0.5),
        'ssm_c_re': nrm(ks[14], (DEPTH, SSM_GROUPS, SSM_GROUP, SSM_STATE), (2.0 * SSM_STATE) ** -0.5),
        'ssm_c_im': nrm(ks[15], (DEPTH, SSM_GROUPS, SSM_GROUP, SSM_STATE), (2.0 * SSM_STATE) ** -0.5),
        'ssm_d': nrm(ks[16], (DEPTH, D_SSM), 1.0),
        'ssm_log_dt': jax.random.uniform(ks[17], (DEPTH, SSM_GROUPS), f32, math.log(1e-3), math.log(1e-1)),
        'ssm_w_glu': nrm(ks[18], (DEPTH, D_SSM, 2 * D_SSM), D_SSM ** -0.5),
        'lru_conv_w': nrm(ks[19], (DEPTH, CONV_W, D_LRU), 0.5),
        'lru_conv_b': nrm(ks[20], (DEPTH, D_LRU), 0.01),
        'lru_w_a': nrm(ks[21], (DEPTH, LRU_BLOCKS, LRU_BLOCK, LRU_BLOCK), LRU_BLOCK ** -0.5),
        'lru_b_a': nrm(ks[22], (DEPTH, D_LRU), 0.01),
        'lru_w_x': nrm(ks[23], (DEPTH, LRU_BLOCKS, LRU_BLOCK, LRU_BLOCK), LRU_BLOCK ** -0.5),
        'lru_b_x': nrm(ks[24], (DEPTH, D_LRU), 0.01),
        'lru_lambda': jnp.log(sig) - jnp.log1p(-sig),
        'norm_ffn': 1.0 + nrm(ks[25], (DEPTH, D_MODEL), 0.01),
        'w_ffn_gate': nrm(ks[27], (DEPTH, D_MODEL, D_FFN), D_MODEL ** -0.5),
        'w_ffn_up': nrm(ks[28], (DEPTH, D_MODEL, D_FFN), D_MODEL ** -0.5),
        'w_ffn_down': nrm(ks[29], (DEPTH, D_FFN, D_MODEL), D_FFN ** -0.5),
        'norm_final': 1.0 + nrm(ks[30], (D_MODEL,), 0.01),
    }


def reference(x_prompt, x_sample, state_ret, state_ssm, state_lru, cache_conv,
              norm_mix, w_in, mix_scale, w_out,
              ssm_a_re, ssm_a_im, ssm_b_re, ssm_b_im, ssm_c_re, ssm_c_im, ssm_d, ssm_log_dt, ssm_w_glu,
              lru_conv_w, lru_conv_b, lru_w_a, lru_b_a, lru_w_x, lru_b_x, lru_lambda,
              norm_ffn, w_ffn_gate, w_ffn_up, w_ffn_down, norm_final):
    p = {
        'norm_mix': norm_mix, 'w_in': w_in, 'mix_scale': mix_scale, 'w_out': w_out,
        'ssm_a_re': ssm_a_re, 'ssm_a_im': ssm_a_im, 'ssm_b_re': ssm_b_re, 'ssm_b_im': ssm_b_im,
        'ssm_c_re': ssm_c_re, 'ssm_c_im': ssm_c_im, 'ssm_d': ssm_d, 'ssm_log_dt': ssm_log_dt,
        'ssm_w_glu': ssm_w_glu,
        'lru_conv_w': lru_conv_w, 'lru_conv_b': lru_conv_b, 'lru_w_a': lru_w_a, 'lru_b_a': lru_b_a,
        'lru_w_x': lru_w_x, 'lru_b_x': lru_b_x, 'lru_lambda': lru_lambda,
        'norm_ffn': norm_ffn, 'w_ffn_gate': w_ffn_gate, 'w_ffn_up': w_ffn_up, 'w_ffn_down': w_ffn_down,
        'norm_final': norm_final,
    }
    bp = x_prompt.shape[0]
    z_ret = jnp.zeros((DEPTH, bp, RET_HEADS, RET_HEAD_DIM, RET_HEAD_DIM), jnp.float32)
    z_ssm = jnp.zeros((DEPTH, bp, SSM_GROUPS, SSM_STATE, 2), jnp.float32)
    z_lru = jnp.zeros((DEPTH, bp, D_LRU), jnp.float32)
    z_conv = jnp.zeros((DEPTH, bp, CONV_W - 1, D_LRU), jnp.float32)
    y_prompt, p_ret, p_ssm, p_lru, p_conv = _trunk(x_prompt, 0, z_ret, z_ssm, z_lru, z_conv, p)
    y_sample, s_ret, s_ssm, s_lru, s_conv = _trunk(x_sample, PAST_LEN, state_ret, state_ssm, state_lru, cache_conv, p)
    return (y_prompt, y_sample, p_ret, p_ssm, p_lru, p_conv, s_ret, s_ssm, s_lru, s_conv)
```

```cpp
#include <hip/hip_runtime.h>
#include <hip/hip_cooperative_groups.h>
#include <cstdio>
#include <cstdint>
namespace cg = cooperative_groups;

#ifndef MK_MULTI
#define MK_MULTI 0
#endif

#ifndef PROBE_PRO
#define PROBE_PRO 0
#endif
#ifndef PROBE_M12
#define PROBE_M12 0
#endif
#ifndef REP_SUB
#define REP_SUB -1
#endif
#define LAS __attribute__((address_space(3)))
typedef unsigned short bf16_t;
typedef short bf16x8 __attribute__((ext_vector_type(8)));
typedef float f32x4 __attribute__((ext_vector_type(4)));
typedef float f32x2 __attribute__((ext_vector_type(2)));
typedef unsigned u32x4 __attribute__((ext_vector_type(4)));
typedef unsigned u32x2 __attribute__((ext_vector_type(2)));

constexpr int DM = 1024, MP = 32768, MTOT = 34816, DIN = 2816, DFF = 2816, DEPTH = 4;
constexpr int NSUB = 7, NPH = 2 + NSUB * DEPTH;
constexpr size_t O_PRET = 35651584, O_PSSM = 39845888, O_PLRU = 39976960, O_PCONV = 39993344;
constexpr size_t O_SRET = 40042496, O_SSSM = 48431104, O_SLRU = 48693248, O_SCONV = 48726016;
constexpr size_t MiB = 1u << 20;
constexpr size_t WS_ROT = 3 * MiB;
constexpr size_t WS_LAMB = 4 * MiB;
constexpr size_t WS_BB = 4 * MiB + 64 * 1024;
constexpr size_t WS_CP = 4 * MiB + 640 * 1024;
constexpr size_t WS_LRUW = 4 * MiB + 896 * 1024;
constexpr size_t WS_W = 6 * MiB;
constexpr size_t WL_IN = 0, WL_OUT = 5767168, WL_GU = WL_OUT + 2097152, WL_DN = WL_GU + 11534336, WL_GLU = WL_DN + 5767168, WL_STRIDE = WL_GLU + 262144;
constexpr size_t WS_XB = 104 * MiB, WS_MIXED = 172 * MiB, WS_Y = 240 * MiB, WS_PROJ = 258 * MiB;
constexpr size_t WS_SQMIX = 445 * MiB, WS_SQFFN = 446 * MiB, WS_GA = 447 * MiB, WS_GB = 448 * MiB, WS_GC = 449 * MiB;
constexpr size_t OUT_U = 0, OUT_CUMA = 32 * MiB  , WS_HLOC = 452 * MiB, WS_S5E = 488 * MiB  , WS_LSUM = 487 * MiB, WS_END = 492 * MiB;
static_assert(WS_W + 4 * WL_STRIDE <= WS_XB, "ws map");
__device__ __forceinline__ float sum4(const f32x4 v) { return (v[0] + v[1]) + (v[2] + v[3]); }

struct Params { const float* in[31]; float* out; unsigned char* ws; int ph_lo, ph_hi; };
typedef const __attribute__((address_space(4))) Params* KP;

__device__ __forceinline__ int opaque_tid() { int t = threadIdx.x; asm volatile("" : "+v"(t)); return t; }
__device__ __forceinline__ unsigned cvt_pk_bf16(float lo, float hi) { unsigned r; asm volatile("v_cvt_pk_bf16_f32 %0, %1, %2" : "=v"(r) : "v"(lo), "v"(hi)); return r; }
__device__ __forceinline__ bf16_t f2bf(float f) { return (bf16_t)(cvt_pk_bf16(f, 0.f) & 0xffffu); }
__device__ __forceinline__ float bf2f(bf16_t h) { return __builtin_bit_cast(float, (unsigned)h << 16); }
__device__ __forceinline__ float bflo(unsigned w) { return __builtin_bit_cast(float, w << 16); }
__device__ __forceinline__ float bfhi(unsigned w) { return __builtin_bit_cast(float, w & 0xffff0000u); }
__device__ __forceinline__ float sigmoidf_(float x) { return __builtin_amdgcn_rcpf(1.f + __expf(-x)); }
__device__ __forceinline__ float siluf_(float x) { return x * sigmoidf_(x); }
__device__ __forceinline__ float geluf_(float x) { return x * sigmoidf_(1.5957691216f * (x + 0.044715f * x * x * x)); }
__device__ __forceinline__ f32x4 mfma16(bf16x8 a, bf16x8 b, f32x4 c) { return __builtin_amdgcn_mfma_f32_16x16x32_bf16(a, b, c, 0, 0, 0); }

namespace pg8 {
constexpr int BM = 256, BK = 64, HALF = 128, HTB = HALF * BK * 2, STAGE_BYTES = 8 * HTB, NXCD = 8, WGM = 8;
__host__ __device__ __forceinline__ int lds_byte(int r, int c) { const int st = (r >> 4) * 2 + (c >> 5), rr = r & 15, cc = c & 31, ob = rr * 64 + cc * 2; return st * 1024 + (ob ^ (((ob >> 9) & 1) << 5)); }
__host__ __device__ __forceinline__ void stage_rc(int b, int& R, int& C) { const int st = b / 1024, sb = b % 1024, swz = sb ^ (((sb >> 9) & 1) << 5); R = (st >> 1) * 16 + swz / 64; C = (st & 1) * 32 + (swz % 64) / 2; }
__host__ __device__ __forceinline__ int perm32(int rho) { const int n = rho >> 4, i = rho & 15; return 8 * (i >> 2) + 4 * n + (i & 3); }
struct Unit { int pm, pn; };
struct Gemm { const bf16_t* A; const bf16_t* Bt; int M, N, K; int ld = 0; };
struct StaticOrder {
    int nM, nN, nwg, G, c;
    __device__ void init(int M, int N, int G_, int c_) { nM = M / BM; nN = N / BM; nwg = nM * nN; G = G_; c = c_; }
    __device__ bool next(int i, Unit& u) const {
        const long L = (long)i * G + c; if (L >= nwg) return false;
        int wgid = (int)L; { const int q = nwg / NXCD, r = nwg % NXCD, xcd = wgid % NXCD, off = wgid / NXCD; wgid = (xcd < r ? xcd * (q + 1) : r * (q + 1) + (xcd - r) * q) + off; }
        const int nig = WGM * nN, gid = wgid / nig, fm = gid * WGM, gsz = (nM - fm) < WGM ? (nM - fm) : WGM;
        u.pm = fm + ((wgid % nig) % gsz); u.pn = (wgid % nig) / gsz; return true;
    }
};
template <class Epi>
__device__ __forceinline__ void gemm_phase(LAS unsigned char* lds, const Gemm g, const StaticOrder& S, const Epi& E) {
    const int tid = opaque_tid(), wid = __builtin_amdgcn_readfirstlane(tid >> 6), lane = tid & 63, wr = wid >> 2, wc = wid & 3, fr = lane & 15, fq = lane >> 4;
    const int K = g.ld ? g.ld : g.K, nt = g.K / BK;
    unsigned voffA[2], voffB[2];
#pragma unroll
    for (int i = 0; i < 2; ++i) { int R, C; stage_rc(tid * 16 + i * 8192, R, C); const int Rb = Epi::PERM ? ((R & ~31) + perm32(R & 31)) : R;
        voffA[i] = (unsigned)(R * K + C) * 2u; voffB[i] = (unsigned)(Rb * K + C) * 2u; }
    const size_t kstep = (size_t)(BK * 2);
    const size_t hstep = (size_t)HALF * K * 2;
    const size_t tstep = 2 * hstep;
    const unsigned ldsw = (unsigned)wid * 1024u;
    const int aoff = lds_byte(wr * 64 + fr, fq * 8), boff = lds_byte(wc * 32 + fr, fq * 8);
#define PG8_SA(b, h) (((b) * 2 + (h)) * HTB)
#define PG8_SB(b, h) ((4 + (b) * 2 + (h)) * HTB)
#define PG8_STAGE(bufoff, gbase, voff) do { _Pragma("unroll") for (int _i = 0; _i < 2; ++_i) \
        __builtin_amdgcn_global_load_lds((const unsigned*)((const char*)(gbase) + (voff)[_i]), (LAS unsigned*)(lds + (bufoff) + ldsw + _i * 8192), 16, 0, 0); } while (0)
#define PG8_LDA(dst, b, h) do { _Pragma("unroll") for (int m = 0; m < 4; ++m) _Pragma("unroll") for (int k = 0; k < 2; ++k) dst[m][k] = *(const LAS bf16x8*)(lds + PG8_SA(b, h) + aoff + m * 2048 + k * 1024); } while (0)
#define PG8_LDB(dst, b, h) do { _Pragma("unroll") for (int n = 0; n < 2; ++n) _Pragma("unroll") for (int k = 0; k < 2; ++k) dst[n][k] = *(const LAS bf16x8*)(lds + PG8_SB(b, h) + boff + n * 2048 + k * 1024); } while (0)
#define PG8_MMA(ai, bj, At, Bt) do { __builtin_amdgcn_s_setprio(1); _Pragma("unroll") for (int m = 0; m < 4; ++m) _Pragma("unroll") for (int n = 0; n < 2; ++n) _Pragma("unroll") for (int k = 0; k < 2; ++k) \
        acc[ai][bj][m][n] = __builtin_amdgcn_mfma_f32_16x16x32_bf16(Bt[n][k], At[m][k], acc[ai][bj][m][n], 0, 0, 0); __builtin_amdgcn_s_setprio(0); } while (0)
#define PG8_WAIT_V(n) asm volatile("s_waitcnt vmcnt(" #n ")" ::: "memory")
#define PG8_WAIT_L(n) asm volatile("s_waitcnt lgkmcnt(" #n ")" ::: "memory")
#define PG8_BAR __builtin_amdgcn_s_barrier()
#define PG8_SCHED __builtin_amdgcn_sched_barrier(0)
    Unit cur, nxt; int ui = 0;
    if (!S.next(0, cur)) return;
    f32x4 acc[2][2][4][2];
#pragma unroll
    for (int a = 0; a < 2; ++a)
#pragma unroll
        for (int b = 0; b < 2; ++b)
#pragma unroll
            for (int m = 0; m < 4; ++m)
#pragma unroll
                for (int n = 0; n < 2; ++n) acc[a][b][m][n] = (f32x4){0.f, 0.f, 0.f, 0.f};
    bf16x8 At[4][2], B0[2][2], B1[2][2];
    const size_t kh = (size_t)g.K * 2;
    const char* cA = (const char*)g.A + (size_t)cur.pm * tstep + (Epi::SPLITK ? (size_t)(cur.pn >> 2) * kh : 0); const char* cB = (const char*)g.Bt + (size_t)(Epi::SPLITK ? (cur.pn & 3) : cur.pn) * tstep + (Epi::SPLITK ? (size_t)(cur.pn >> 2) * kh : 0);
    PG8_STAGE(PG8_SB(0, 0), cB, voffB); PG8_STAGE(PG8_SB(0, 1), cB + hstep, voffB); PG8_STAGE(PG8_SA(0, 0), cA, voffA); PG8_STAGE(PG8_SA(0, 1), cA + hstep, voffA);
    if (wr == 1) PG8_BAR;
    PG8_WAIT_V(2); PG8_BAR;
    PG8_STAGE(PG8_SB(1, 0), cB + kstep, voffB); PG8_STAGE(PG8_SA(1, 0), cA + kstep, voffA); PG8_STAGE(PG8_SB(1, 1), cB + hstep + kstep, voffB);
    PG8_WAIT_V(6); PG8_BAR;
    for (;;) {
        const bool has_next = S.next(ui + 1, nxt);
        const char* nA = has_next ? (const char*)g.A + (size_t)nxt.pm * tstep + (Epi::SPLITK ? (size_t)(nxt.pn >> 2) * kh : 0) : cA; const char* nB = has_next ? (const char*)g.Bt + (size_t)(Epi::SPLITK ? (nxt.pn & 3) : nxt.pn) * tstep + (Epi::SPLITK ? (size_t)(nxt.pn >> 2) * kh : 0) : cB;
#pragma unroll 1
        for (int t = 0; t < nt; t += 2) {
            const bool last = (t == nt - 2);
            const char* a1 = cA + (size_t)(t + 1) * kstep;
            const char* a2 = last ? nA : cA + (size_t)(t + 2) * kstep; const char* b2 = last ? nB : cB + (size_t)(t + 2) * kstep;
            const char* a3 = a2 + kstep; const char* b3 = b2 + kstep;
            if constexpr (Epi::HOOK) { E.khook(acc, t, cur, wr, fr); PG8_SCHED; }
            PG8_LDB(B0, 0, 0); PG8_LDB(B1, 0, 1); PG8_SCHED; PG8_LDA(At, 0, 0); PG8_STAGE(PG8_SA(1, 1), a1 + hstep, voffA);
            PG8_WAIT_V(8); PG8_WAIT_L(0); PG8_BAR; PG8_MMA(0, 0, At, B0); PG8_MMA(0, 1, At, B1); PG8_BAR; PG8_SCHED;
            PG8_LDA(At, 0, 1); PG8_STAGE(PG8_SB(0, 0), b2, voffB); PG8_STAGE(PG8_SB(0, 1), b2 + hstep, voffB); PG8_STAGE(PG8_SA(0, 0), a2, voffA);
            PG8_WAIT_V(8); PG8_WAIT_L(0); PG8_BAR; PG8_MMA(1, 0, At, B0); PG8_MMA(1, 1, At, B1); PG8_BAR; PG8_SCHED;
            PG8_LDB(B0, 1, 0); PG8_LDB(B1, 1, 1); PG8_SCHED; PG8_LDA(At, 1, 0); PG8_STAGE(PG8_SA(0, 1), a2 + hstep, voffA);
            PG8_WAIT_V(8); PG8_WAIT_L(0); PG8_BAR; PG8_MMA(0, 0, At, B0); PG8_MMA(0, 1, At, B1); PG8_BAR; PG8_SCHED;
            PG8_LDA(At, 1, 1); PG8_STAGE(PG8_SB(1, 0), b3, voffB); PG8_STAGE(PG8_SB(1, 1), b3 + hstep, voffB); PG8_STAGE(PG8_SA(1, 0), a3, voffA);
            PG8_WAIT_V(8); PG8_WAIT_L(0); PG8_BAR; PG8_MMA(1, 0, At, B0); PG8_MMA(1, 1, At, B1); PG8_BAR; PG8_SCHED;
        }
        if (wr == 0) PG8_BAR;
        E(acc, cur, wr, wc, fr, fq);
        if (!has_next) break;
#pragma unroll
        for (int a = 0; a < 2; ++a)
#pragma unroll
            for (int b = 0; b < 2; ++b)
#pragma unroll
                for (int m = 0; m < 4; ++m)
#pragma unroll
                    for (int n = 0; n < 2; ++n) acc[a][b][m][n] = (f32x4){0.f, 0.f, 0.f, 0.f};
        cur = nxt; cA = nA; cB = nB; ++ui;
        if (wr == 1) PG8_BAR;
    }
    PG8_WAIT_V(0);
    PG8_BAR;
#undef PG8_SA
#undef PG8_SB
#undef PG8_STAGE
#undef PG8_LDA
#undef PG8_LDB
#undef PG8_MMA
#undef PG8_WAIT_V
#undef PG8_WAIT_L
#undef PG8_BAR
#undef PG8_SCHED
}
}
using pg8::Unit;
typedef f32x4 Acc[2][2][4][2];

struct EpiProj {
    static constexpr bool PERM = true, HOOK = false, SPLITK = false;
    bf16_t* O; const f32x4* sq; const f32x4* rot;
    __device__ __forceinline__ void operator()(const Acc& acc, const Unit& u, int wr, int wc, int fr, int fq) const {
        const int row0 = u.pm * 256 + wr * 64 + fr, pn = u.pn;
        if (pn < 4) {
            const float qs = (pn < 2) ? 0.08838834764831845f : 1.f;
            const int idx0 = 32 * (wc & 1) + 8 * fq;
            const int lcol = 256 * pn + 128 * (wc >> 1) + idx0;
#pragma unroll
            for (int ai = 0; ai < 2; ++ai)
#pragma unroll
                for (int m = 0; m < 4; ++m) {
                    const int row = row0 + ai * 128 + m * 16;
                    const float rs = rsqrtf(sum4(sq[row]) * (1.f / 1024.f) + 1e-6f) * qs;
                    const int pos = row < MP ? (row & 2047) : 1024 + ((row - MP) & 63);
                    const f32x4* rp = rot + pos * 32 + (idx0 >> 1);
                    const f32x4 c0 = rp[0], c1 = rp[1], c2 = rp[2], c3 = rp[3];
                    const f32x4 a0 = acc[ai][0][m][0] * rs, a1 = acc[ai][0][m][1] * rs, b0 = acc[ai][1][m][0] * rs, b1 = acc[ai][1][m][1] * rs;
                    u32x4 w1, w2;
                    w1.x = cvt_pk_bf16(a0[0] * c0[0] - b0[0] * c0[1], a0[1] * c0[2] - b0[1] * c0[3]);
                    w1.y = cvt_pk_bf16(a0[2] * c1[0] - b0[2] * c1[1], a0[3] * c1[2] - b0[3] * c1[3]);
                    w1.z = cvt_pk_bf16(a1[0] * c2[0] - b1[0] * c2[1], a1[1] * c2[2] - b1[1] * c2[3]);
                    w1.w = cvt_pk_bf16(a1[2] * c3[0] - b1[2] * c3[1], a1[3] * c3[2] - b1[3] * c3[3]);
                    w2.x = cvt_pk_bf16(b0[0] * c0[0] + a0[0] * c0[1], b0[1] * c0[2] + a0[1] * c0[3]);
                    w2.y = cvt_pk_bf16(b0[2] * c1[0] + a0[2] * c1[1], b0[3] * c1[2] + a0[3] * c1[3]);
                    w2.z = cvt_pk_bf16(b1[0] * c2[0] + a1[0] * c2[1], b1[1] * c2[2] + a1[1] * c2[3]);
                    w2.w = cvt_pk_bf16(b1[2] * c3[0] + a1[2] * c3[1], b1[3] * c3[2] + a1[3] * c3[3]);
                    bf16_t* op = O + (size_t)row * DIN + lcol;
                    *(u32x4*)op = w1; *(u32x4*)(op + 64) = w2;
                }
        } else {
            const int col0 = 256 * pn + 32 * wc + 8 * fq;
#pragma unroll
            for (int ai = 0; ai < 2; ++ai)
#pragma unroll
                for (int m = 0; m < 4; ++m) {
                    const int row = row0 + ai * 128 + m * 16;
                    const float rs = rsqrtf(sum4(sq[row]) * (1.f / 1024.f) + 1e-6f);
                    bf16_t* op = O + (size_t)row * DIN + col0;
#pragma unroll
                    for (int bj = 0; bj < 2; ++bj) { const f32x4 v0 = acc[ai][bj][m][0] * rs, v1 = acc[ai][bj][m][1] * rs; u32x4 w;
                        w.x = cvt_pk_bf16(v0[0], v0[1]); w.y = cvt_pk_bf16(v0[2], v0[3]); w.z = cvt_pk_bf16(v1[0], v1[1]); w.w = cvt_pk_bf16(v1[2], v1[3]);
                        *(u32x4*)(op + bj * 128) = w; }
                }
        }
    }
};
template <bool GRP> struct EpiRes {
    static constexpr bool PERM = false, HOOK = GRP, SPLITK = false;
    float* X  ; bf16_t* XB  ; float* sqn; const f32x4* gA; const f32x2* gB; const float* gC; LAS float* part;
    __device__ __forceinline__ float gcsum(unsigned row) const { return gC[row]; }
    __device__ __forceinline__ void khook(Acc& acc, int t, const Unit& u, int wr, int fr) const {
        if (t == 8 || t == 12) {
            asm volatile("" : "+v"(fr));
#pragma unroll
            for (int ai = 0; ai < 2; ++ai)
#pragma unroll
                for (int m = 0; m < 4; ++m) {
                    const unsigned row = (unsigned)(u.pm * 256 + ai * 128 + wr * 64 + m * 16 + fr);
                    const f32x2 gb = gB[row]; const float sB = (gb[0] + gb[1]) * (1.f / 256.f) + 1e-6f;
                    float ratio;
                    if (t == 8) ratio = sqrtf(sB / (sum4(gA[row]) * (1.f / 512.f) + 1e-6f));
                    else ratio = sqrtf((gcsum(row) * (1.f / 256.f) + 1e-6f) / sB);
                    asm volatile("" ::: "memory");
#pragma unroll
                    for (int bj = 0; bj < 2; ++bj)
#pragma unroll
                        for (int n = 0; n < 2; ++n) acc[ai][bj][m][n] *= ratio;
                }
        }
    }
    __device__ __forceinline__ void operator()(const Acc& acc, const Unit& u, int wr, int wc, int fr, int fq) const {
        const int row0 = u.pm * 256 + wr * 64 + fr, col0 = u.pn * 256 + wc * 32 + 4 * fq;
#pragma unroll
        for (int ai = 0; ai < 2; ++ai)
#pragma unroll
            for (int m = 0; m < 4; ++m) {
                const int row = row0 + ai * 128 + m * 16;
                float sc = 1.f; if (GRP) sc = rsqrtf(gcsum((unsigned)row) * (1.f / 256.f) + 1e-6f);
                const unsigned off = (unsigned)row * DM + col0; float ss = 0.f;
#pragma unroll
                for (int bj = 0; bj < 2; ++bj)
#pragma unroll
                    for (int n = 0; n < 2; ++n) {
                        const u32x2 xr = *(const u32x2*)(XB + off + bj * 128 + n * 16);
                        const f32x4 xo = (f32x4){bflo(xr[0]), bfhi(xr[0]), bflo(xr[1]), bfhi(xr[1])};
                        const f32x4 xn = xo + acc[ai][bj][m][n] * sc;
                        if (X) *(f32x4*)(X + off + bj * 128 + n * 16) = xn;
                        u32x2 w; w.x = cvt_pk_bf16(xn[0], xn[1]); w.y = cvt_pk_bf16(xn[2], xn[3]);
                        *(u32x2*)(XB + off + bj * 128 + n * 16) = w;
                        ss += (xn[0] * xn[0] + xn[1] * xn[1]) + (xn[2] * xn[2] + xn[3] * xn[3]);
                    }
                ss += __shfl_xor(ss, 16); ss += __shfl_xor(ss, 32);
                if (fq == 0) part[wc * 256 + ai * 128 + wr * 64 + m * 16 + fr] = ss;
                asm volatile("" ::: "memory");
            }
        asm volatile("s_waitcnt lgkmcnt(0)" ::: "memory"); __builtin_amdgcn_s_barrier(); asm volatile("" ::: "memory");
        { const int t_ = (wr * 4 + wc) * 64 + fq * 16 + fr;
          if (t_ < 256) sqn[(size_t)(u.pm * 256 + t_) * 4 + u.pn] = (part[t_] + part[256 + t_]) + (part[512 + t_] + part[768 + t_]); }
        asm volatile("s_waitcnt lgkmcnt(0)" ::: "memory"); __builtin_amdgcn_s_barrier(); asm volatile("" ::: "memory");
    }
};
struct EpiPart {
    static constexpr bool PERM = false, HOOK = false, SPLITK = true;
    float* PART;
    __device__ __forceinline__ void operator()(const Acc& acc, const Unit& u, int wr, int wc, int fr, int fq) const {
        float* base = PART + (size_t)((u.pn >> 2) * 32 + u.pm * 4 + (u.pn & 3)) * 65536 + (wr * 64 + fr) * 256 + wc * 32 + 4 * fq;
#pragma unroll
        for (int ai = 0; ai < 2; ++ai)
#pragma unroll
            for (int m = 0; m < 4; ++m)
#pragma unroll
                for (int bj = 0; bj < 2; ++bj)
#pragma unroll
                    for (int n = 0; n < 2; ++n) *(f32x4*)(base + (ai * 128 + m * 16) * 256 + bj * 128 + n * 16) = acc[ai][bj][m][n];
    }
};
struct EpiSwiGLU {
    static constexpr bool PERM = true, HOOK = false, SPLITK = false;
    bf16_t* O; const f32x4* sq;
    __device__ __forceinline__ void operator()(const Acc& acc, const Unit& u, int wr, int wc, int fr, int fq) const {
        const int row0 = u.pm * 256 + wr * 64 + fr, col0 = 128 * u.pn + 32 * wc + 8 * fq;
#pragma unroll
        for (int ai = 0; ai < 2; ++ai)
#pragma unroll
            for (int m = 0; m < 4; ++m) {
                const int row = row0 + ai * 128 + m * 16;
                const float rs = rsqrtf(sum4(sq[row]) * (1.f / 1024.f) + 1e-6f);
                float o[8];
#pragma unroll
                for (int n = 0; n < 2; ++n)
#pragma unroll
                    for (int i = 0; i < 4; ++i) { const float gt = acc[ai][0][m][n][i] * rs, up = acc[ai][1][m][n][i] * rs; o[4 * n + i] = siluf_(gt) * up; }
                u32x4 w; w.x = cvt_pk_bf16(o[0], o[1]); w.y = cvt_pk_bf16(o[2], o[3]); w.z = cvt_pk_bf16(o[4], o[5]); w.w = cvt_pk_bf16(o[6], o[7]);
                *(u32x4*)(O + (size_t)row * DFF + col0) = w;
            }
    }
};
struct EpiGLU {
    static constexpr bool PERM = true, HOOK = false, SPLITK = false;
    bf16_t* O; float* gB; LAS float* part;
    __device__ __forceinline__ void operator()(const Acc& acc, const Unit& u, int wr, int wc, int fr, int fq) const {
        const int row0 = u.pm * 256 + wr * 64 + fr, col0 = 512 + 128 * u.pn + 32 * wc + 8 * fq;
#pragma unroll
        for (int ai = 0; ai < 2; ++ai)
#pragma unroll
            for (int m = 0; m < 4; ++m) {
                const int row = row0 + ai * 128 + m * 16;
                float o[8]; float ss = 0.f;
#pragma unroll
                for (int n = 0; n < 2; ++n)
#pragma unroll
                    for (int i = 0; i < 4; ++i) { const float v = acc[ai][0][m][n][i] * sigmoidf_(acc[ai][1][m][n][i]); o[4 * n + i] = v; ss += v * v; }
                u32x4 w; w.x = cvt_pk_bf16(o[0], o[1]); w.y = cvt_pk_bf16(o[2], o[3]); w.z = cvt_pk_bf16(o[4], o[5]); w.w = cvt_pk_bf16(o[6], o[7]);
                *(u32x4*)(O + (size_t)row * DM + col0) = w;
                ss += __shfl_xor(ss, 16); ss += __shfl_xor(ss, 32);
                if (fq == 0) part[wc * 256 + ai * 128 + wr * 64 + m * 16 + fr] = ss;
            }
        asm volatile("s_waitcnt lgkmcnt(0)" ::: "memory"); __builtin_amdgcn_s_barrier(); asm volatile("" ::: "memory");
        { const int t_ = (wr * 4 + wc) * 64 + fq * 16 + fr;
          if (t_ < 256) gB[(size_t)(u.pm * 256 + t_) * 2 + u.pn] = (part[t_] + part[256 + t_]) + (part[512 + t_] + part[768 + t_]); }
        asm volatile("s_waitcnt lgkmcnt(0)" ::: "memory"); __builtin_amdgcn_s_barrier(); asm volatile("" ::: "memory");
    }
};

__device__ __forceinline__ float wave_sum(float v) {
#pragma unroll
    for (int o = 1; o < 64; o <<= 1) v += __shfl_xor(v, o);
    return v;
}
__device__ __forceinline__ void tr_item(const float* W, int ldw, int srccol0, const float* gain, bf16_t* WT, int K, int drow0, int k0, LAS float* scr, int lane) {
    { const int r8 = lane >> 3, c4 = (lane & 7) * 4;
#pragma unroll
      for (int i = 0; i < 8; ++i) { const int kk = 8 * i + r8; f32x4 v = *(const f32x4*)(W + (size_t)(k0 + kk) * ldw + srccol0 + c4); if (gain) v *= gain[k0 + kk];
          scr[kk * 33 + c4] = v[0]; scr[kk * 33 + c4 + 1] = v[1]; scr[kk * 33 + c4 + 2] = v[2]; scr[kk * 33 + c4 + 3] = v[3]; } }
    asm volatile("s_waitcnt lgkmcnt(0)" ::: "memory");
    const int c = lane & 7;
#pragma unroll
    for (int j = 0; j < 4; ++j) { const int n = (lane >> 3) + 8 * j; const LAS float* s = scr + (8 * c) * 33 + n;
        u32x4 o; o.x = cvt_pk_bf16(s[0 * 33], s[1 * 33]); o.y = cvt_pk_bf16(s[2 * 33], s[3 * 33]); o.z = cvt_pk_bf16(s[4 * 33], s[5 * 33]); o.w = cvt_pk_bf16(s[6 * 33], s[7 * 33]);
        *(u32x4*)(WT + (size_t)(drow0 + n) * K + k0 + 8 * c) = o; }
    asm volatile("s_waitcnt lgkmcnt(0)" ::: "memory");
}
__device__ __forceinline__ void convert_layer_weights(LAS unsigned char* lds, KP P, int L, int first, int stride, int wave, int lane) {
    unsigned char* ws = P->ws;
    LAS float* scr = (LAS float*)(lds + wave * 16384);
    constexpr int I_IN = 16 * 88, I_OUT = 16 * 32, I_GU = 16 * 176, I_DN = 44 * 32, I_GLU = 4 * 16, I_L = I_IN + I_OUT + I_GU + I_DN + I_GLU;
    unsigned char* wl = ws + WS_W + (size_t)L * WL_STRIDE;
    for (int it = first; it < I_L; it += stride) {
        int r = it;
        if (r < I_IN) { const int kb = r / 88, d = (r % 88) * 32; int sc0 = d;
            if (d < 1024) { const int pn = d >> 8, pc = d & 255, wcc = (pc >> 5) & 3, bj = pc >> 7; sc0 = 256 * pn + 128 * (wcc >> 1) + 64 * bj + 32 * (wcc & 1); }
            tr_item(P->in[7] + (size_t)L * DM * DIN, DIN, sc0, P->in[6] + L * DM, (bf16_t*)(wl + WL_IN), DM, d, 64 * kb, scr, lane); continue; }
        r -= I_IN;
        if (r < I_OUT) { const int kb = r / 32, d = (r % 32) * 32;
            tr_item(P->in[9] + (size_t)L * DM * DM, DM, d, P->in[8] + L * DM, (bf16_t*)(wl + WL_OUT), DM, d, 64 * kb, scr, lane); continue; }
        r -= I_OUT;
        if (r < I_GU) { const int kb = r / 176, d = (r % 176) * 32; const int pn = d >> 8, pc = d & 255, bj = pc >> 7; const int ch0 = 128 * pn + (pc & 127);
            tr_item((bj ? P->in[28] : P->in[27]) + (size_t)L * DM * DFF, DFF, ch0, P->in[26] + L * DM, (bf16_t*)(wl + WL_GU), DM, d, 64 * kb, scr, lane); continue; }
        r -= I_GU;
        if (r < I_DN) { const int kb = r / 32, d = (r % 32) * 32;
            tr_item(P->in[29] + (size_t)L * DFF * DM, DM, d, nullptr, (bf16_t*)(wl + WL_DN), DFF, d, 64 * kb, scr, lane); continue; }
        r -= I_DN;
        { const int kb = r / 16, d = (r % 16) * 32; const int pn = d >> 8, pc = d & 255, bj = pc >> 7; const int sc0 = 256 * bj + 128 * pn + (pc & 127);
            tr_item(P->in[18] + (size_t)L * 256 * 512, 512, sc0, nullptr, (bf16_t*)(wl + WL_GLU), 256, d, 64 * kb, scr, lane); }
    }
}
__device__ __forceinline__ void prologue(LAS unsigned char* lds, KP P) {
    const int tid = opaque_tid(), lane = tid & 63, wave = __builtin_amdgcn_readfirstlane(tid >> 6);
    const int G = gridDim.x, gw = blockIdx.x * 8 + wave, NGW = G * 8;
    const int gt = blockIdx.x * 512 + tid, NGT = G * 512;
    unsigned char* ws = P->ws;
    convert_layer_weights(lds, P, 0, gw, NGW, wave, lane);
    { bf16_t* o = (bf16_t*)(ws + WS_LRUW);
      for (int e = gt; e < DEPTH * 4 * 128 * 64; e += NGT) { const int L = e >> 15, hb = (e >> 13) & 3, n = (e >> 6) & 127, i = e & 63;
          const float* src = (n < 64) ? P->in[21] : P->in[23]; o[e] = f2bf(src[(((size_t)L * 4 + hb) * 64 + i) * 64 + (n & 63)]); } }
    for (int e = gt; e < DEPTH * 16 * 64; e += NGT) {
        const int L = e >> 10, g = (e >> 6) & 15, p = e & 63;
        const float are = P->in[10][e], aim = P->in[11][e];
        const float dt = __expf(P->in[17][L * 16 + g]);
        const float mag = expf(are * dt); float ang = aim * dt; const float rev = ang * 0.15915494309189535f; ang = (rev - rintf(rev)) * 6.283185307179586f;
        const float lr = mag * cosf(ang), li = mag * sinf(ang);
        ((f32x2*)(ws + WS_LAMB))[e] = (f32x2){lr, li};
        const float nr = lr - 1.f, ni = li, den = 1.f / (are * are + aim * aim);
        const float cr = (nr * are + ni * aim) * den, ci = (ni * are - nr * aim) * den;
        bf16_t* bb = (bf16_t*)(ws + WS_BB) + ((size_t)(L * 16 + g) * 128) * 32;
        const float* bre = P->in[12] + (size_t)e * 16; const float* bim = P->in[13] + (size_t)e * 16;
        for (int j = 0; j < 16; ++j) { const float br = bre[j], bi = bim[j]; bb[p * 32 + j] = f2bf(cr * br - ci * bi); bb[(64 + p) * 32 + j] = f2bf(cr * bi + ci * br); bb[p * 32 + 16 + j] = 0; bb[(64 + p) * 32 + 16 + j] = 0; }
        bf16_t* cp = (bf16_t*)(ws + WS_CP) + ((size_t)(L * 16 + g) * 16) * 128;
        const float* cre = P->in[14] + ((size_t)(L * 16 + g) * 16) * 64; const float* cim = P->in[15] + ((size_t)(L * 16 + g) * 16) * 64;
        for (int c = 0; c < 16; ++c) { cp[c * 128 + p] = f2bf(cre[c * 64 + p]); cp[c * 128 + 64 + p] = f2bf(-cim[c * 64 + p]); }
    }
    for (int e = gt; e < 2048 * 64; e += NGT) { const int pos = e >> 6, idx = e & 63;
        const float inv = exp2f(-(float)idx * (13.287712379549449f / 64.f)); const float ang = (float)pos * inv;
        const double rev = (double)ang * 0.15915494309189535; const float fr_ = (float)(rev - rint(rev)) * 6.283185307179586f;
        ((f32x2*)(ws + WS_ROT))[e] = (f32x2){cosf(fr_), sinf(fr_)}; }
    { bf16_t* XB = (bf16_t*)(ws + WS_XB); f32x4* sq0 = (f32x4*)(ws + WS_SQMIX);
      for (int m = gw; m < MTOT; m += NGW) {
          const float* xr = (m < MP) ? P->in[0] + (size_t)m * DM : P->in[1] + (size_t)(m - MP) * DM;
          float s = 0.f;
#pragma unroll
          for (int j = 0; j < 4; ++j) { const f32x4 v = ((const f32x4*)xr)[lane + 64 * j]; s += (v[0] * v[0] + v[1] * v[1]) + (v[2] * v[2] + v[3] * v[3]);
              u32x2 w; w.x = cvt_pk_bf16(v[0], v[1]); w.y = cvt_pk_bf16(v[2], v[3]); ((u32x2*)(XB + (size_t)m * DM))[lane + 64 * j] = w; }
          s = wave_sum(s); if (lane == 0) sq0[m] = (f32x4){s, 0.f, 0.f, 0.f}; } }
}

constexpr int R_QS = 0, R_KS = 17408, R_KT = 34816, R_VT = 53248, R_PS = 71680, R_ST = 80896, R_RED = 115712, R_RED2 = 116736;
__device__ __forceinline__ void ret_stage_kv(LAS unsigned char* lds, const u32x4 (&gk)[2], const u32x4 (&gv)[2], int lj, int lc, float kd) {
#pragma unroll
    for (int i = 0; i < 2; ++i) {
        const int c8 = lc + 8 * i;
#pragma unroll
        for (int x = 0; x < 4; ++x) {
            const unsigned kw = gk[i][x], vw = gv[i][x];
            const unsigned kp = cvt_pk_bf16(bflo(kw) * kd, bfhi(kw) * kd);
            *(LAS bf16_t*)(lds + R_KT + (8 * c8 + 2 * x) * 144 + lj * 2) = (bf16_t)(kp & 0xffffu);
            *(LAS bf16_t*)(lds + R_KT + (8 * c8 + 2 * x + 1) * 144 + lj * 2) = (bf16_t)(kp >> 16);
            *(LAS bf16_t*)(lds + R_VT + (8 * c8 + 2 * x) * 144 + lj * 2) = (bf16_t)(vw & 0xffffu);
            *(LAS bf16_t*)(lds + R_VT + (8 * c8 + 2 * x + 1) * 144 + lj * 2) = (bf16_t)(vw >> 16);
        }
    }
}
__device__ __forceinline__ void ret_state_update(LAS unsigned char* lds, f32x4 (&S)[8], int wid, int fr, int fq, float g64) {
    bf16x8 kf[2];
#pragma unroll
    for (int ks = 0; ks < 2; ++ks) kf[ks] = *(const LAS bf16x8*)(lds + R_KT + (16 * wid + fr) * 144 + (32 * ks + 8 * fq) * 2);
#pragma unroll
    for (int tv = 0; tv < 8; ++tv) { S[tv] *= g64;
#pragma unroll
        for (int ks = 0; ks < 2; ++ks) { const bf16x8 vf = *(const LAS bf16x8*)(lds + R_VT + (16 * tv + fr) * 144 + (32 * ks + 8 * fq) * 2); S[tv] = mfma16(kf[ks], vf, S[tv]); } }
}
constexpr int RSEG_N = 6;
__device__ __forceinline__ int rseg_start(int seg) { return seg < 2 ? 6 * seg : 12 + 5 * (seg - 2); }
__device__ __forceinline__ int rseg_len(int seg) { return seg < 2 ? 6 : 5; }
__device__ __forceinline__ void ret_pass1(LAS unsigned char* lds, KP P, int L, int s, int h, int seg) {
    const int tid = opaque_tid(), wid = __builtin_amdgcn_readfirstlane(tid >> 6), lane = tid & 63, fr = lane & 15, fq = lane >> 4;
    const int R0 = s * 2048 + 64 * rseg_start(seg), nch1 = rseg_len(seg);
    const float log2g = log2f(1.f - exp2f(-5.f - (float)h));
    const bf16_t* PROJ = (const bf16_t*)(P->ws + WS_PROJ);
    f32x4 S[8];
#pragma unroll
    for (int tv = 0; tv < 8; ++tv) S[tv] = (f32x4){0.f, 0.f, 0.f, 0.f};
    const int lj = tid & 63, lc = tid >> 6;
    u32x4 gk[2], gv[2];
    { const bf16_t* rp = PROJ + (size_t)(R0 + lj) * DIN + 128 * h + 8 * lc;
#pragma unroll
      for (int i = 0; i < 2; ++i) { gk[i] = *(const u32x4*)(rp + 512 + 64 * i); gv[i] = *(const u32x4*)(rp + 1024 + 64 * i); } }
    const float g64 = exp2f(log2g * 64.f), kd = exp2f(log2g * (float)(63 - lj));
    for (int c = 0; c < nch1; ++c) {
        __syncthreads();
        ret_stage_kv(lds, gk, gv, lj, lc, kd);
        __syncthreads();
        if (c + 1 < nch1) { const bf16_t* rp = PROJ + (size_t)(R0 + 64 * (c + 1) + lj) * DIN + 128 * h + 8 * lc;
#pragma unroll
            for (int i = 0; i < 2; ++i) { gk[i] = *(const u32x4*)(rp + 512 + 64 * i); gv[i] = *(const u32x4*)(rp + 1024 + 64 * i); } }
        ret_state_update(lds, S, wid, fr, fq, g64);
    }
    float* U = (float*)((unsigned char*)P->out + OUT_U) + (size_t)((s * 4 + h) * 8 + seg) * 16384;
#pragma unroll
    for (int tv = 0; tv < 8; ++tv)
#pragma unroll
        for (int jj = 0; jj < 4; ++jj) U[(tv * 4 + jj) * 512 + tid] = S[tv][jj];
}
__device__ __forceinline__ void ret_item(LAS unsigned char* lds, KP P, int L, int s, int h, int seg) {
    const int tid = opaque_tid(), wid = __builtin_amdgcn_readfirstlane(tid >> 6), lane = tid & 63, fr = lane & 15, fq = lane >> 4;
    const bool prompt = s < 16;
    const int R0 = prompt ? s * 2048 + 64 * rseg_start(seg) : MP + (s - 16) * 64, nch = prompt ? rseg_len(seg) : 1;
    const float log2g = log2f(1.f - exp2f(-5.f - (float)h));
    const bf16_t* PROJ = (const bf16_t*)(P->ws + WS_PROJ);
    bf16_t* MIXED = (bf16_t*)(P->ws + WS_MIXED);
    float* gA = (float*)(P->ws + WS_GA);
    f32x4 S[8];
#pragma unroll
    for (int tv = 0; tv < 8; ++tv) S[tv] = (f32x4){0.f, 0.f, 0.f, 0.f};
    if (prompt) {
        const float* U = (const float*)((unsigned char*)P->out + OUT_U) + (size_t)((s * 4 + h) * 8) * 16384 + tid;
        float un[32];
        if (seg > 0) {
#pragma unroll
            for (int e = 0; e < 32; ++e) un[e] = U[e * 512];
        }
        for (int w = 0; w < seg; ++w) {
            const float pw = exp2f(log2g * 64.f * (float)(rseg_start(seg) - rseg_start(w + 1)));
            float uc[32];
#pragma unroll
            for (int e = 0; e < 32; ++e) uc[e] = un[e];
            if (w + 1 < seg) {
#pragma unroll
                for (int e = 0; e < 32; ++e) un[e] = U[(size_t)(w + 1) * 16384 + e * 512];
            }
#pragma unroll
            for (int tv = 0; tv < 8; ++tv)
#pragma unroll
                for (int jj = 0; jj < 4; ++jj) S[tv][jj] += pw * uc[tv * 4 + jj];
        }
    } else {
        const float* sp = P->in[2] + ((size_t)(L * 32 + (s - 16)) * 4 + h) * 16384;
#pragma unroll
        for (int tv = 0; tv < 8; ++tv)
#pragma unroll
            for (int jj = 0; jj < 4; ++jj) S[tv][jj] = sp[(16 * wid + 4 * fq + jj) * 128 + 16 * tv + fr];
    }
    const int lj = tid & 63, lc = tid >> 6;
    u32x4 gq[2], gk[2], gv[2];
    { const bf16_t* rp = PROJ + (size_t)(R0 + lj) * DIN + 128 * h + 8 * lc;
#pragma unroll
      for (int i = 0; i < 2; ++i) { gq[i] = *(const u32x4*)(rp + 64 * i); gk[i] = *(const u32x4*)(rp + 512 + 64 * i); gv[i] = *(const u32x4*)(rp + 1024 + 64 * i); } }
    const float g64 = exp2f(log2g * 64.f), kd = exp2f(log2g * (float)(63 - lj));
    for (int c = 0; c < nch; ++c) {
        __syncthreads();
        {
#pragma unroll
            for (int i = 0; i < 2; ++i) {
                const int c8 = lc + 8 * i;
                *(LAS u32x4*)(lds + R_QS + lj * 272 + c8 * 16) = gq[i];
                *(LAS u32x4*)(lds + R_KS + lj * 272 + c8 * 16) = gk[i];
            }
            ret_stage_kv(lds, gk, gv, lj, lc, kd);
#pragma unroll
            for (int tv = 0; tv < 8; ++tv) { u32x2 w; w.x = cvt_pk_bf16(S[tv][0], S[tv][1]); w.y = cvt_pk_bf16(S[tv][2], S[tv][3]);
                *(LAS u32x2*)(lds + R_ST + (16 * tv + fr) * 272 + (16 * wid + 4 * fq) * 2) = w; }
        }
        __syncthreads();
        if (c + 1 < nch) { const bf16_t* rp = PROJ + (size_t)(R0 + 64 * (c + 1) + lj) * DIN + 128 * h + 8 * lc;
#pragma unroll
            for (int i = 0; i < 2; ++i) { gq[i] = *(const u32x4*)(rp + 64 * i); gk[i] = *(const u32x4*)(rp + 512 + 64 * i); gv[i] = *(const u32x4*)(rp + 1024 + 64 * i); } }
        const int ti = wid >> 1;
        {
            const int tj0 = 2 * (wid & 1);
            f32x4 sc[2] = {(f32x4){0.f, 0.f, 0.f, 0.f}, (f32x4){0.f, 0.f, 0.f, 0.f}};
#pragma unroll
            for (int ks = 0; ks < 4; ++ks) { const bf16x8 qf = *(const LAS bf16x8*)(lds + R_QS + (16 * ti + fr) * 272 + (32 * ks + 8 * fq) * 2);
#pragma unroll
                for (int t2 = 0; t2 < 2; ++t2) { const bf16x8 kf = *(const LAS bf16x8*)(lds + R_KS + (16 * (tj0 + t2) + fr) * 272 + (32 * ks + 8 * fq) * 2); sc[t2] = mfma16(kf, qf, sc[t2]); } }
#pragma unroll
            for (int t2 = 0; t2 < 2; ++t2) { const int i_ = 16 * ti + fr, j0 = 16 * (tj0 + t2) + 4 * fq; float pv[4];
#pragma unroll
                for (int jj = 0; jj < 4; ++jj) pv[jj] = sc[t2][jj] * exp2f(log2g * fabsf((float)(i_ - (j0 + jj))));
                u32x2 w; w.x = cvt_pk_bf16(pv[0], pv[1]); w.y = cvt_pk_bf16(pv[2], pv[3]);
                *(LAS u32x2*)(lds + R_PS + i_ * 144 + j0 * 2) = w; }
        }
        ret_state_update(lds, S, wid, fr, fq, g64);
        __syncthreads();
        const int vh = wid & 1;
        const int irow = 16 * ti + fr, grow = R0 + 64 * c + irow;
        u32x2 gg[4];
#pragma unroll
        for (int t4 = 0; t4 < 4; ++t4) gg[t4] = *(const u32x2*)(PROJ + (size_t)grow * DIN + 1536 + 128 * h + 16 * (4 * vh + t4) + 4 * fq);
        f32x4 oi[4], oc[4];
#pragma unroll
        for (int t4 = 0; t4 < 4; ++t4) { oi[t4] = (f32x4){0.f, 0.f, 0.f, 0.f}; oc[t4] = (f32x4){0.f, 0.f, 0.f, 0.f}; }
#pragma unroll
        for (int ks = 0; ks < 2; ++ks) { const bf16x8 pf = *(const LAS bf16x8*)(lds + R_PS + (16 * ti + fr) * 144 + (32 * ks + 8 * fq) * 2);
#pragma unroll
            for (int t4 = 0; t4 < 4; ++t4) { const bf16x8 vf = *(const LAS bf16x8*)(lds + R_VT + (16 * (4 * vh + t4) + fr) * 144 + (32 * ks + 8 * fq) * 2); oi[t4] = mfma16(vf, pf, oi[t4]); } }
#pragma unroll
        for (int ks = 0; ks < 4; ++ks) { const bf16x8 qf = *(const LAS bf16x8*)(lds + R_QS + (16 * ti + fr) * 272 + (32 * ks + 8 * fq) * 2);
#pragma unroll
            for (int t4 = 0; t4 < 4; ++t4) { const bf16x8 sf = *(const LAS bf16x8*)(lds + R_ST + (16 * (4 * vh + t4) + fr) * 272 + (32 * ks + 8 * fq) * 2); oc[t4] = mfma16(sf, qf, oc[t4]); } }
        const float qd = exp2f(log2g * (float)(irow + 1));
        float s1 = 0.f, s2 = 0.f;
#pragma unroll
        for (int t4 = 0; t4 < 4; ++t4) { oi[t4] = oi[t4] + oc[t4] * qd;
#pragma unroll
            for (int jj = 0; jj < 4; ++jj) { s1 += oi[t4][jj]; s2 += oi[t4][jj] * oi[t4][jj]; } }
        s1 += __shfl_xor(s1, 16); s1 += __shfl_xor(s1, 32); s2 += __shfl_xor(s2, 16); s2 += __shfl_xor(s2, 32);
        LAS f32x2* red = (LAS f32x2*)(lds + R_RED);
        if (fq == 0) red[irow * 2 + vh] = (f32x2){s1, s2};
        __syncthreads();
        const f32x2 ra = red[irow * 2], rb2 = red[irow * 2 + 1];
        const float mean = (ra[0] + rb2[0]) * (1.f / 128.f);
        const float var = (ra[1] + rb2[1]) * (1.f / 128.f) - mean * mean;
        const float rstd = rsqrtf(fmaxf(var, 0.f) + 1e-5f);
        float ss = 0.f;
#pragma unroll
        for (int t4 = 0; t4 < 4; ++t4) {
            const float g0 = bflo(gg[t4][0]), g1 = bfhi(gg[t4][0]), g2 = bflo(gg[t4][1]), g3 = bfhi(gg[t4][1]);
            const float y0 = (oi[t4][0] - mean) * rstd * siluf_(g0), y1 = (oi[t4][1] - mean) * rstd * siluf_(g1);
            const float y2 = (oi[t4][2] - mean) * rstd * siluf_(g2), y3 = (oi[t4][3] - mean) * rstd * siluf_(g3);
            ss += (y0 * y0 + y1 * y1) + (y2 * y2 + y3 * y3);
            u32x2 w; w.x = cvt_pk_bf16(y0, y1); w.y = cvt_pk_bf16(y2, y3);
            *(u32x2*)(MIXED + (size_t)grow * DM + 128 * h + 16 * (4 * vh + t4) + 4 * fq) = w;
        }
        ss += __shfl_xor(ss, 16); ss += __shfl_xor(ss, 32);
        LAS float* red2 = (LAS float*)(lds + R_RED2);
        if (fq == 0) red2[irow * 2 + vh] = ss;
        __syncthreads();
        if (tid < 64) gA[(size_t)(R0 + 64 * c + tid) * 4 + h] = red2[tid * 2] + red2[tid * 2 + 1];
    }
    if (!prompt || seg == RSEG_N - 1) { float* so = P->out + (prompt ? O_PRET + ((size_t)(L * 16 + s) * 4 + h) * 16384 : O_SRET + ((size_t)(L * 32 + (s - 16)) * 4 + h) * 16384);
#pragma unroll
      for (int tv = 0; tv < 8; ++tv)
#pragma unroll
          for (int jj = 0; jj < 4; ++jj) so[(16 * wid + 4 * fq + jj) * 128 + 16 * tv + fr] = S[tv][jj]; }
}

__device__ __forceinline__ void s5_chain(LAS unsigned char* hs  , KP P, int L, int s, int g, int lane, int sc0, int sc1, LAS f32x2* st) {
    if (sc0 >= sc1) return;
    const int fr = lane & 15, fq = lane >> 4;
    const bool prompt = s < 16;
    const int R0 = prompt ? s * 2048 : MP + (s - 16) * 64, nsub = prompt ? 128 : 4;
    const bf16_t* PROJ = (const bf16_t*)(P->ws + WS_PROJ);
    bf16_t* Yb = (bf16_t*)(P->ws + WS_Y);
    const bf16_t* Bb = (const bf16_t*)(P->ws + WS_BB) + ((size_t)(L * 16 + g) * 128) * 32;
    const bf16_t* Cp = (const bf16_t*)(P->ws + WS_CP) + ((size_t)(L * 16 + g) * 16) * 128;
    bf16x8 bfr[8], cfr[4];
#pragma unroll
    for (int nt = 0; nt < 8; ++nt) bfr[nt] = *(const bf16x8*)(Bb + (16 * nt + fr) * 32 + 8 * fq);
#pragma unroll
    for (int ks = 0; ks < 4; ++ks) cfr[ks] = *(const bf16x8*)(Cp + fr * 128 + 32 * ks + 8 * fq);
    float lre[4], lim[4], hre[4], him[4], dsk[4];
#pragma unroll
    for (int n = 0; n < 4; ++n) { const f32x2 l2 = ((const f32x2*)(P->ws + WS_LAMB))[(L * 16 + g) * 64 + 16 * n + fr]; lre[n] = l2[0]; lim[n] = l2[1]; hre[n] = 0.f; him[n] = 0.f; }
    if (!prompt) {
#pragma unroll
        for (int n = 0; n < 4; ++n) { const float* sp = P->in[3] + (((size_t)(L * 32 + (s - 16)) * 16 + g) * 64 + 16 * n + fr) * 2; hre[n] = sp[0]; him[n] = sp[1]; }
    } else if (sc0 > 0) {
#pragma unroll
        for (int n = 0; n < 4; ++n) { const f32x2 e = st[16 * n + fr]; hre[n] = e[0]; him[n] = e[1]; }
    }
#pragma unroll
    for (int jj = 0; jj < 4; ++jj) dsk[jj] = P->in[16][L * 256 + 16 * g + 4 * fq + jj];
    float pwr[4][4], pwi[4][4];
#pragma unroll
    for (int n = 0; n < 4; ++n) { pwr[n][0] = lre[n]; pwi[n][0] = lim[n];
#pragma unroll
        for (int jj = 1; jj < 4; ++jj) { pwr[n][jj] = pwr[n][jj - 1] * lre[n] - pwi[n][jj - 1] * lim[n]; pwi[n][jj] = pwr[n][jj - 1] * lim[n] + pwi[n][jj - 1] * lre[n]; } }
    const bf16_t* up0 = PROJ + (size_t)(R0 + fr) * DIN + 2048 + 16 * g;
    bf16x8 uf_n = (bf16x8){0, 0, 0, 0, 0, 0, 0, 0};
    if (fq < 2) uf_n = *(const bf16x8*)(up0 + (size_t)(16 * sc0) * DIN + 8 * fq);
    u32x2 u4_n = *(const u32x2*)(up0 + (size_t)(16 * sc0) * DIN + 4 * fq);
    for (int sc = sc0; sc < sc1; ++sc) {
        const int r0 = R0 + 16 * sc;
        const bf16x8 uf = uf_n; const u32x2 u4 = u4_n;
        if (sc + 1 < sc1) { const bf16_t* up = up0 + (size_t)(16 * (sc + 1)) * DIN; if (fq < 2) uf_n = *(const bf16x8*)(up + 8 * fq); u4_n = *(const u32x2*)(up + 4 * fq); }
        f32x4 bu[8];
#pragma unroll
        for (int nt = 0; nt < 8; ++nt) bu[nt] = mfma16(uf, bfr[nt], (f32x4){0.f, 0.f, 0.f, 0.f});
#pragma unroll
        for (int n = 0; n < 4; ++n) {
            float Lr[4], Li[4];
            Lr[0] = bu[n][0]; Li[0] = bu[n + 4][0];
#pragma unroll
            for (int jj = 1; jj < 4; ++jj) { Lr[jj] = lre[n] * Lr[jj - 1] - lim[n] * Li[jj - 1] + bu[n][jj]; Li[jj] = lre[n] * Li[jj - 1] + lim[n] * Lr[jj - 1] + bu[n + 4][jj]; }
            float Er[4], Ei[4];
#pragma unroll
            for (int k = 0; k < 4; ++k) { Er[k] = __shfl(Lr[3], 16 * k + fr); Ei[k] = __shfl(Li[3], 16 * k + fr); }
            float hr_ = hre[n], hi_ = him[n], myr = hr_, myi = hi_;
#pragma unroll
            for (int k = 0; k < 4; ++k) { const float nr = pwr[n][3] * hr_ - pwi[n][3] * hi_ + Er[k], ni = pwr[n][3] * hi_ + pwi[n][3] * hr_ + Ei[k]; hr_ = nr; hi_ = ni; if (fq == k + 1) { myr = hr_; myi = hi_; } }
            hre[n] = hr_; him[n] = hi_;
#pragma unroll
            for (int jj = 0; jj < 4; ++jj) { const float cr = Lr[jj] + (pwr[n][jj] * myr - pwi[n][jj] * myi), ci = Li[jj] + (pwr[n][jj] * myi + pwi[n][jj] * myr);
                const unsigned pk = cvt_pk_bf16(cr, ci);
                *(LAS bf16_t*)(hs + (4 * fq + jj) * 272 + (16 * n + fr) * 2) = (bf16_t)pk; *(LAS bf16_t*)(hs + (4 * fq + jj) * 272 + (64 + 16 * n + fr) * 2) = (bf16_t)(pk >> 16); }
        }
        asm volatile("s_waitcnt lgkmcnt(0)" ::: "memory");
        f32x4 y = (f32x4){0.f, 0.f, 0.f, 0.f};
#pragma unroll
        for (int ks = 0; ks < 4; ++ks) { const bf16x8 hf = *(const LAS bf16x8*)(hs + fr * 272 + (32 * ks + 8 * fq) * 2); y = mfma16(cfr[ks], hf, y); }
        asm volatile("s_waitcnt lgkmcnt(0)" ::: "memory");
        const float u0 = bflo(u4[0]), u1 = bfhi(u4[0]), u2 = bflo(u4[1]), u3 = bfhi(u4[1]);
        u32x2 w; w.x = cvt_pk_bf16(geluf_(y[0] + dsk[0] * u0), geluf_(y[1] + dsk[1] * u1)); w.y = cvt_pk_bf16(geluf_(y[2] + dsk[2] * u2), geluf_(y[3] + dsk[3] * u3));
        *(u32x2*)(Yb + (size_t)(r0 + fr) * 256 + 16 * g + 4 * fq) = w;
    }
    if (sc1 < nsub) {
        if (fq == 0) {
#pragma unroll
            for (int n = 0; n < 4; ++n) st[16 * n + fr] = (f32x2){hre[n], him[n]}; }
    } else if (fq == 0) { float* so = P->out + (prompt ? O_PSSM + ((size_t)(L * 16 + s) * 16 + g) * 128 : O_SSSM + ((size_t)(L * 32 + (s - 16)) * 16 + g) * 128);
#pragma unroll
        for (int n = 0; n < 4; ++n) { so[(16 * n + fr) * 2] = hre[n]; so[(16 * n + fr) * 2 + 1] = him[n]; } }
}

__device__ __forceinline__ void lru_m1(KP P, int L, int s, int hb, int q, int lane, int seg) {
    const int fr = lane & 15, fq = lane >> 4;
    const bool prompt = s < 16;
    const int Rs = prompt ? s * 2048 : MP + (s - 16) * 64, tb = prompt ? 256 * seg : 0, nsub = prompt ? 16 : 4;
    const bf16_t* PROJ = (const bf16_t*)(P->ws + WS_PROJ);
    unsigned* HC = (unsigned*)(P->ws + WS_HLOC);
    const int ch = 64 * hb + 16 * q + fr;
    const bf16_t* WT = (const bf16_t*)(P->ws + WS_LRUW) + ((size_t)(L * 4 + hb) * 128) * 64;
    bf16x8 wf[2][2];
#pragma unroll
    for (int tl = 0; tl < 2; ++tl)
#pragma unroll
        for (int ks = 0; ks < 2; ++ks) wf[tl][ks] = *(const bf16x8*)(WT + (64 * tl + 16 * q + fr) * 64 + 32 * ks + 8 * fq);
    const float* cwp = P->in[19] + (size_t)L * 4 * 256;
    const float* cbp = P->in[20] + L * 256;
    float cwo[4];
#pragma unroll
    for (int w = 0; w < 4; ++w) cwo[w] = cwp[w * 256 + ch];
    const float cbo = cbp[ch], ba = P->in[22][L * 256 + ch], bxb = P->in[24][L * 256 + ch];
    const float lam = P->in[25][L * 256 + ch];
    const float sp = fmaxf(-lam, 0.f) + log1pf(__expf(-fabsf(lam)));
    float hc = 0.f, ac = 1.f;
    const float* cbuf = P->in[5] + (size_t)(L * 32 + (prompt ? 0 : (s - 16))) * 3 * 256;
    u32x4 xa[2][4]; bf16_t xr[7];
    f32x4 cwa[2][4][2], cba[2][2];
#pragma unroll
    for (int ks = 0; ks < 2; ++ks) { const int ci = 64 * hb + 32 * ks + 8 * fq; cba[ks][0] = *(const f32x4*)(cbp + ci); cba[ks][1] = *(const f32x4*)(cbp + ci + 4);
#pragma unroll
        for (int w = 0; w < 4; ++w) { cwa[ks][w][0] = *(const f32x4*)(cwp + w * 256 + ci); cwa[ks][w][1] = *(const f32x4*)(cwp + w * 256 + ci + 4); } }
#define LRU_LOAD(t0_) do { \
        _Pragma("unroll") for (int ks = 0; ks < 2; ++ks) { const int ci = 64 * hb + 32 * ks + 8 * fq; \
            _Pragma("unroll") for (int w = 0; w < 4; ++w) { const int tt = (t0_) + fr + w - 3; \
                if (tt >= 0) xa[ks][w] = *(const u32x4*)(PROJ + (size_t)(Rs + tt) * DIN + 2304 + ci); \
                else if (!prompt) { const f32x4 c0 = *(const f32x4*)(cbuf + (tt + 3) * 256 + ci), c1 = *(const f32x4*)(cbuf + (tt + 3) * 256 + ci + 4); \
                    xa[ks][w] = (u32x4){cvt_pk_bf16(c0[0], c0[1]), cvt_pk_bf16(c0[2], c0[3]), cvt_pk_bf16(c1[0], c1[1]), cvt_pk_bf16(c1[2], c1[3])}; } \
                else xa[ks][w] = (u32x4){0u, 0u, 0u, 0u}; } } \
        _Pragma("unroll") for (int e = 0; e < 7; ++e) { const int tt = (t0_) + 4 * fq - 3 + e; \
            if (tt >= 0) xr[e] = PROJ[(size_t)(Rs + tt) * DIN + 2304 + ch]; \
            else if (!prompt) xr[e] = f2bf(cbuf[(tt + 3) * 256 + ch]); \
            else xr[e] = 0; } } while (0)
    LRU_LOAD(tb);
    for (int sc = 0; sc < nsub; ++sc) {
        const int t0 = tb + 16 * sc, r0 = Rs + t0;
        bf16x8 xf[2];
#pragma unroll
        for (int ks = 0; ks < 2; ++ks) {
            const int ci = 64 * hb + 32 * ks + 8 * fq;
            float xv[8];
            { const f32x4 b0 = cba[ks][0], b1 = cba[ks][1];
#pragma unroll
              for (int x = 0; x < 4; ++x) { xv[x] = b0[x]; xv[4 + x] = b1[x]; } }
#pragma unroll
            for (int w = 0; w < 4; ++w) {
                const f32x4 w0 = cwa[ks][w][0], w1 = cwa[ks][w][1];
                const u32x4 pv = xa[ks][w];
                xv[0] += w0[0] * bflo(pv[0]); xv[1] += w0[1] * bfhi(pv[0]); xv[2] += w0[2] * bflo(pv[1]); xv[3] += w0[3] * bfhi(pv[1]);
                xv[4] += w1[0] * bflo(pv[2]); xv[5] += w1[1] * bfhi(pv[2]); xv[6] += w1[2] * bflo(pv[3]); xv[7] += w1[3] * bfhi(pv[3]);
            }
            u32x4 pk; pk.x = cvt_pk_bf16(xv[0], xv[1]); pk.y = cvt_pk_bf16(xv[2], xv[3]); pk.z = cvt_pk_bf16(xv[4], xv[5]); pk.w = cvt_pk_bf16(xv[6], xv[7]);
            xf[ks] = __builtin_bit_cast(bf16x8, pk);
        }
        float xco[4];
#pragma unroll
        for (int jj = 0; jj < 4; ++jj) xco[jj] = cbo + cwo[0] * bf2f(xr[jj]) + cwo[1] * bf2f(xr[jj + 1]) + cwo[2] * bf2f(xr[jj + 2]) + cwo[3] * bf2f(xr[jj + 3]);
        if (sc + 1 < nsub) LRU_LOAD(t0 + 16);
        f32x4 pre[2];
#pragma unroll
        for (int tl = 0; tl < 2; ++tl) { pre[tl] = mfma16(xf[0], wf[tl][0], (f32x4){0.f, 0.f, 0.f, 0.f}); pre[tl] = mfma16(xf[1], wf[tl][1], pre[tl]); }
        float av[4], bv[4];
#pragma unroll
        for (int jj = 0; jj < 4; ++jj) {
            const float r = sigmoidf_(pre[0][jj] + ba), ig = sigmoidf_(pre[1][jj] + bxb);
            const float la = -8.f * r * sp;
            av[jj] = __expf(la);
            bv[jj] = sqrtf(fmaxf(1.f - av[jj] * av[jj], 0.f)) * ig * xco[jj];
        }
        float hr[4] = {0.f, 0.f, 0.f, 0.f}, ar[4] = {0.f, 0.f, 0.f, 0.f};
#pragma unroll
        for (int r = 0; r < 4; ++r) { float cur = hc, ca = ac;
#pragma unroll
            for (int jj = 0; jj < 4; ++jj) { cur = av[jj] * cur + bv[jj]; ca *= av[jj]; if (fq == r) { hr[jj] = cur; ar[jj] = ca; } }
            hc = __shfl(cur, 16 * r + fr); ac = __shfl(ca, 16 * r + fr); }
#pragma unroll
        for (int jj = 0; jj < 4; ++jj) { const size_t o = (size_t)(r0 + 4 * fq + jj) * 256 + ch; HC[o] = cvt_pk_bf16(hr[jj], ar[jj]); }
    }
#undef LRU_LOAD
    if (fq == 0) ((f32x2*)(P->ws + WS_LSUM))[(size_t)(s * 8 + seg) * 256 + ch] = (f32x2){ac, hc};
}
__device__ __forceinline__ void lru_m2(KP P, int L, int gidx, int lane) {
    const int row0 = 16 * gidx;
    const bool prompt = row0 < MP;
    const int s = prompt ? (row0 >> 11) : 16 + ((row0 - MP) >> 6), t = prompt ? (row0 & 2047) : ((row0 - MP) & 63), seg = prompt ? (t >> 8) : 0, len = prompt ? 2048 : 64;
    const bf16_t* PROJ = (const bf16_t*)(P->ws + WS_PROJ);
    bf16_t* MIXED = (bf16_t*)(P->ws + WS_MIXED);
    const unsigned* HC = (const unsigned*)(P->ws + WS_HLOC);
    float* gC = (float*)(P->ws + WS_GC);
    f32x4 hin = (f32x4){0.f, 0.f, 0.f, 0.f};
    if (!prompt) hin = *(const f32x4*)(P->in[4] + (size_t)(L * 32 + (s - 16)) * 256 + 4 * lane);
    else { const f32x2* SUMS = (const f32x2*)(P->ws + WS_LSUM) + (size_t)(s * 8) * 256 + 4 * lane;
        for (int w = 0; w < seg; ++w) {
#pragma unroll
            for (int i = 0; i < 4; ++i) { const f32x2 ab = SUMS[w * 256 + i]; hin[i] = ab[0] * hin[i] + ab[1]; } } }
    f32x4 hlast = hin;
    for (int r = 0; r < 16; ++r) {
        const int row = row0 + r;
        const u32x4 hc = *(const u32x4*)(HC + (size_t)row * 256 + 4 * lane);
        const u32x2 gt = *(const u32x2*)(PROJ + (size_t)row * DIN + 2560 + 4 * lane);
        f32x4 h; h[0] = bflo(hc[0]) + bfhi(hc[0]) * hin[0]; h[1] = bflo(hc[1]) + bfhi(hc[1]) * hin[1]; h[2] = bflo(hc[2]) + bfhi(hc[2]) * hin[2]; h[3] = bflo(hc[3]) + bfhi(hc[3]) * hin[3];
        const float o0 = h[0] * geluf_(bflo(gt[0])), o1 = h[1] * geluf_(bfhi(gt[0])), o2 = h[2] * geluf_(bflo(gt[1])), o3 = h[3] * geluf_(bfhi(gt[1]));
        u32x2 w; w.x = cvt_pk_bf16(o0, o1); w.y = cvt_pk_bf16(o2, o3);
        *(u32x2*)(MIXED + (size_t)row * DM + 768 + 4 * lane) = w;
        const float ss = wave_sum((o0 * o0 + o1 * o1) + (o2 * o2 + o3 * o3));
        if (lane == 0) gC[row] = ss;
        hlast = h;
    }
    if (t + 16 == len) {
        const int sb = prompt ? s : s - 16, NB = prompt ? 16 : 32;
        *(f32x4*)(P->out + (prompt ? O_PLRU : O_SLRU) + (size_t)(L * NB + sb) * 256 + 4 * lane) = hlast;
#pragma unroll
        for (int tau = 0; tau < 3; ++tau) { const u32x2 xv = *(const u32x2*)(PROJ + (size_t)(row0 + 13 + tau) * DIN + 2304 + 4 * lane);
            *(f32x4*)(P->out + (prompt ? O_PCONV : O_SCONV) + ((size_t)(L * NB + sb) * 3 + tau) * 256 + 4 * lane) = (f32x4){bflo(xv[0]), bfhi(xv[0]), bflo(xv[1]), bfhi(xv[1])}; }
    }
}

constexpr int S5_NS1 = MK_MULTI ? 128 : 72;
__device__ __forceinline__ void mixer1_phase(LAS unsigned char* lds, KP P, int L) {
    const int G = gridDim.x, b = blockIdx.x, NO = G - (G + 3) / 4;
    const int tid_ = opaque_tid(); const int wave = __builtin_amdgcn_readfirstlane(tid_ >> 6), lane = tid_ & 63;
    if ((b & 3) == 0) { const int chain = wave * 64 + (b >> 2); if (wave < 4 && chain < 256) s5_chain(lds + wave * 4352, P, L, chain >> 4, chain & 15, lane, 0, S5_NS1, (LAS f32x2*)(lds + 36864 + wave * 512)); return; }
    const int nb = b - (b >> 2) - 1;
    for (int id = nb; id < 448; id += NO) {
        if (id < 320) ret_pass1(lds, P, L, id / 20, (id % 20) / 5, id % 5);
        else { const int k = id - 320; ret_item(lds, P, L, 16 + (k >> 2), k & 3, 0); }
    }
    __syncthreads();
    for (int id = wave * NO + nb; id < 3072; id += 8 * NO) {
        if (id < 2048) { const int chain = id >> 3; lru_m1(P, L, chain >> 4, (chain >> 2) & 3, chain & 3, lane, id & 7); }
        else if (id < 2560) { const int k = id - 2048; s5_chain(lds + wave * 4352, P, L, 16 + (k >> 4), k & 15, lane, 0, 4, nullptr); }
        else { const int k = id - 2560; lru_m1(P, L, 16 + (k >> 4), (k >> 2) & 3, k & 3, lane, 0); }
    }
}
__device__ __forceinline__ void mixer2_phase(LAS unsigned char* lds, KP P, int L) {
    const int G = gridDim.x, b = blockIdx.x, NO = G - (G + 3) / 4;
    const int tid_ = opaque_tid(); const int wave = __builtin_amdgcn_readfirstlane(tid_ >> 6), lane = tid_ & 63;
    if ((b & 3) == 0) {
        const int chain = wave * 64 + (b >> 2); if (wave < 4 && chain < 256) s5_chain(lds + wave * 4352, P, L, chain >> 4, chain & 15, lane, S5_NS1, 128, (LAS f32x2*)(lds + 36864 + wave * 512));
        __syncthreads();
        const int NS = (G + 3) / 4;
        for (int id = wave * NS + (b >> 2); id < 2176; id += 8 * NS) lru_m2(P, L, id, lane);
        return; }
    const int nb = b - (b >> 2) - 1;
    for (int id = nb; id < 64 * RSEG_N; id += NO) ret_item(lds, P, L, id / 24, (id % 24) / 6, id % 6);
}
__device__ __forceinline__ void final_phase(KP P) {
    const int tid_ = opaque_tid(); const int lane = tid_ & 63, wave = __builtin_amdgcn_readfirstlane(tid_ >> 6);
    const int gw = blockIdx.x * 8 + wave, NGW = gridDim.x * 8;
    const f32x4* sq = (const f32x4*)(P->ws + WS_SQMIX);
    f32x4 gn[4];
#pragma unroll
    for (int j = 0; j < 4; ++j) gn[j] = ((const f32x4*)P->in[30])[lane + 64 * j];
    const bf16_t* XB = (const bf16_t*)(P->ws + WS_XB);
    for (int m = gw; m < MTOT; m += NGW) {
        const float rs = rsqrtf(sum4(sq[m]) * (1.f / 1024.f) + 1e-6f);
        const u32x2* xb = (const u32x2*)(XB + (size_t)m * DM);
        f32x4* yr = (f32x4*)(P->out + (size_t)m * DM);
#pragma unroll
        for (int j = 0; j < 4; ++j) { const u32x2 w = xb[lane + 64 * j]; const f32x4 v = (f32x4){bflo(w[0]), bfhi(w[0]), bflo(w[1]), bfhi(w[1])}; yr[lane + 64 * j] = v * rs * gn[j]; }
    }
}

__device__ __forceinline__ void combine_phase(KP P) {
    const int tid_ = opaque_tid(); const int lane = tid_ & 63, wave = __builtin_amdgcn_readfirstlane(tid_ >> 6);
    const int gw = blockIdx.x * 8 + wave, NGW = gridDim.x * 8;
    const float* PART = (const float*)P->out; bf16_t* XB = (bf16_t*)(P->ws + WS_XB); float* sqn = (float*)(P->ws + WS_SQMIX);
    for (int it = gw; it < 2048 * 4; it += NGW) {
        const int r = it >> 2, pn = it & 3, row = MP + r;
        const float* p0 = PART + (size_t)((r >> 8) * 4 + pn) * 65536 + (r & 255) * 256 + 4 * lane;
        const f32x4 a = *(const f32x4*)p0 + *(const f32x4*)(p0 + (size_t)32 * 65536);
        u32x2* xp = (u32x2*)(XB + (size_t)row * DM + pn * 256 + 4 * lane);
        const u32x2 xv = *xp;
        const f32x4 xn = (f32x4){bflo(xv[0]), bfhi(xv[0]), bflo(xv[1]), bfhi(xv[1])} + a;
        u32x2 w; w.x = cvt_pk_bf16(xn[0], xn[1]); w.y = cvt_pk_bf16(xn[2], xn[3]); *xp = w;
        const float ss = wave_sum((xn[0] * xn[0] + xn[1] * xn[1]) + (xn[2] * xn[2] + xn[3] * xn[3]));
        if (lane == 0) sqn[(size_t)row * 4 + pn] = ss;
    }
}

#define XB_TMO      128
#define XB_XCNT(j)  (256  + 64 * (j))
#define XB_XSUB(j)  (1280 + 64 * (j))
#define XB_XGEN(j)  (2304 + 64 * (j))
#define XB_TOP      3328
#define XB_TOPGEN   3392
#define XCD_BAR_WORDS 3456
#define XB_SPIN_CAP (1u << 18)

__device__ __forceinline__ unsigned xb_ld(unsigned* p)              { return __hip_atomic_load(p, __ATOMIC_RELAXED, __HIP_MEMORY_SCOPE_AGENT); }
__device__ __forceinline__ unsigned xb_add(unsigned* p, unsigned v) { return __hip_atomic_fetch_add(p, v, __ATOMIC_RELAXED, __HIP_MEMORY_SCOPE_AGENT); }
__device__ __forceinline__ unsigned xb_xcc_id() { return (unsigned)__builtin_amdgcn_s_getreg((3 << 11) | 20) & 0xFu; }
#define XB_SPIN(cond, bar) do { unsigned _sp = 0; while (cond) { __builtin_amdgcn_s_sleep(1); \
    if ((++_sp & 255u) == 0u) { if (xb_ld(&(bar)[XB_TMO])) break; if (_sp > XB_SPIN_CAP) { atomicAdd(&(bar)[XB_TMO], 1u); break; } } } } while (0)

struct XcdBarrier {
    unsigned* bar; unsigned x;
    volatile LAS unsigned* st;
};

__device__ __forceinline__ XcdBarrier xcd_barrier_post(unsigned* bar, volatile LAS unsigned* st) {
    XcdBarrier b; b.bar = bar; b.x = xb_xcc_id(); b.st = st;
    if (threadIdx.x == 0) (void)xb_add(&bar[XB_XCNT(b.x)], 1u);
    return b;
}
__device__ __forceinline__ void xcd_barrier_complete(unsigned* bar, unsigned x, unsigned& nloc, unsigned& nx) {
    const unsigned G = gridDim.x * gridDim.y * gridDim.z;
    unsigned sum, cnt, mine, sp = 0u;
    for (;;) {
        sum = 0u; cnt = 0u; mine = 0u;
#pragma unroll
        for (unsigned j = 0; j < 16; ++j) { const unsigned c = xb_ld(&bar[XB_XCNT(j)]); sum += c; cnt += (c > 0u) ? 1u : 0u; mine = (j == x) ? c : mine; }
        if (sum == G) break;
        __builtin_amdgcn_s_sleep(1);
        if ((++sp & 255u) == 0u) { if (xb_ld(&bar[XB_TMO])) break; if (sp > XB_SPIN_CAP) { atomicAdd(&bar[XB_TMO], 1u); break; } }
    }
    nloc = mine > 0u ? mine : 1u; nx = cnt > 0u ? cnt : 1u;
}

__device__ __forceinline__ void xcd_barrier(const XcdBarrier& b) {
    asm volatile("s_waitcnt vmcnt(0)" ::: "memory");
    __syncthreads();
    if (threadIdx.x == 0) {
        unsigned* bar = b.bar;
        __builtin_amdgcn_s_waitcnt(0);
        unsigned nloc = b.st[0], nx = b.st[1];
        if (nloc == 0u) { xcd_barrier_complete(bar, b.x, nloc, nx); b.st[0] = nloc; b.st[1] = nx; }
        const unsigned old = xb_add(&bar[XB_XSUB(b.x)], 1u);
        const unsigned gen = old / nloc;
        if (old + 1u == (gen + 1u) * nloc) {
            __builtin_amdgcn_fence(__ATOMIC_RELEASE, "agent");
            asm volatile("s_waitcnt vmcnt(0)" ::: "memory");
            const unsigned og = xb_add(&bar[XB_TOP], 1u);
            const unsigned tg = og / nx;
            if (og + 1u == (tg + 1u) * nx) xb_add(&bar[XB_TOPGEN], 1u);
            else XB_SPIN(xb_ld(&bar[XB_TOPGEN]) == tg, bar);
            __builtin_amdgcn_fence(__ATOMIC_ACQUIRE, "agent");
            xb_add(&bar[XB_XGEN(b.x)], 1u);
            asm volatile("s_waitcnt vmcnt(0)" ::: "memory");
        } else {
            XB_SPIN(xb_ld(&bar[XB_XGEN(b.x)]) == gen, bar);
            __builtin_amdgcn_fence(__ATOMIC_ACQUIRE, "agent");
            asm volatile("s_waitcnt vmcnt(0)" ::: "memory");
        }
    }
    __syncthreads();
}


constexpr int LDS_BYTES = 131072 + 4096 + 64;
constexpr size_t WS_CTL = 0, CTL_ZERO_BYTES = 16384;
__global__ void __launch_bounds__(512, 2) mk_fwd(Params Pk) {
    extern __shared__ __attribute__((aligned(16))) unsigned char lds_raw[];
    LAS unsigned char* lds = (LAS unsigned char*)lds_raw;
    const int ph_lo = Pk.ph_lo, ph_hi = Pk.ph_hi;
    const KP pp = (KP)__builtin_amdgcn_kernarg_segment_ptr();
#if !MK_MULTI
    volatile LAS unsigned* bst = (volatile LAS unsigned*)(lds + 131072 + 4096);
    if (threadIdx.x < 2) bst[threadIdx.x] = 0u;
    __syncthreads();
    const XcdBarrier gbar = xcd_barrier_post((unsigned*)(Pk.ws + WS_CTL), bst);
#endif
    for (int ph = ph_lo; ph < ph_hi; ++ph) {
        KP P = pp; asm volatile("" : "+s"(P));
        unsigned char* ws = P->ws; const int G = gridDim.x;
        LAS float* part = (LAS float*)(lds + 131072);
        bf16_t* XB = (bf16_t*)(ws + WS_XB); bf16_t* MIXED = (bf16_t*)(ws + WS_MIXED); bf16_t* Yb = (bf16_t*)(ws + WS_Y); bf16_t* PROJ = (bf16_t*)(ws + WS_PROJ);
        for (int rep_ = 0; rep_ < ((ph > 0 && ph < NPH - 1 && (ph - 1) % NSUB == REP_SUB) ? 2 : 1); ++rep_) {
        if (ph == 0) { prologue(lds, P);
#if PROBE_PRO
            __syncthreads(); prologue(lds, P);
#endif
        }
        else if (ph == NPH - 1) final_phase(P);
        else {
            const int L = (ph - 1) / NSUB, sub = (ph - 1) % NSUB;
            unsigned char* wl = ws + WS_W + (size_t)L * WL_STRIDE;
            pg8::StaticOrder S;
            if (sub == 0) {
                pg8::Gemm g{XB, (const bf16_t*)(wl + WL_IN), MTOT, DIN, DM}; S.init(MTOT, DIN, G, (int)blockIdx.x);
                EpiProj E{PROJ, (const f32x4*)(ws + WS_SQMIX), (const f32x4*)(ws + WS_ROT)};
                pg8::gemm_phase<EpiProj>(lds, g, S, E);
            } else if (sub == 1) {
                mixer1_phase(lds, P, L);
            } else if (sub == 2) {
                mixer2_phase(lds, P, L);
#if PROBE_M12 && !MK_MULTI
                xcd_barrier(gbar); mixer1_phase(lds, P, L); xcd_barrier(gbar); mixer2_phase(lds, P, L);
#endif
            } else if (sub == 3) {
                pg8::Gemm g{Yb, (const bf16_t*)(wl + WL_GLU), MTOT, 512, 256}; S.init(MTOT, 512, G, (int)blockIdx.x);
                EpiGLU E{MIXED, (float*)(ws + WS_GB), part};
                pg8::gemm_phase<EpiGLU>(lds, g, S, E);
            } else if (sub == 4) {
                pg8::Gemm g{MIXED, (const bf16_t*)(wl + WL_OUT), MTOT, DM, DM}; S.init(MTOT, DM, G, (int)blockIdx.x);
                EpiRes<true> E{nullptr, XB, (float*)(ws + WS_SQFFN), (const f32x4*)(ws + WS_GA), (const f32x2*)(ws + WS_GB), (const float*)(ws + WS_GC), part};
                pg8::gemm_phase<EpiRes<true>>(lds, g, S, E);
            } else if (sub == 5) {
                pg8::Gemm g{XB, (const bf16_t*)(wl + WL_GU), MTOT, 2 * DFF, DM}; S.init(MTOT, 2 * DFF, G, (int)blockIdx.x);
                EpiSwiGLU E{PROJ  , (const f32x4*)(ws + WS_SQFFN)};
                pg8::gemm_phase<EpiSwiGLU>(lds, g, S, E);
            } else {
#if MK_MULTI
                pg8::Gemm g{PROJ, (const bf16_t*)(wl + WL_DN), MTOT, DM, DFF}; S.init(MTOT, DM, G, (int)blockIdx.x);
                EpiRes<false> E{nullptr, XB, (float*)(ws + WS_SQMIX), nullptr, nullptr, nullptr, part};
                pg8::gemm_phase<EpiRes<false>>(lds, g, S, E);
#else
                { pg8::Gemm g{PROJ, (const bf16_t*)(wl + WL_DN), MP, DM, DFF}; S.init(MP, DM, G, (int)blockIdx.x);
                  EpiRes<false> E{nullptr, XB, (float*)(ws + WS_SQMIX), nullptr, nullptr, nullptr, part};
                  pg8::gemm_phase<EpiRes<false>>(lds, g, S, E); }
                { pg8::Gemm g{PROJ + (size_t)MP * DFF, (const bf16_t*)(wl + WL_DN), 2048, 2048, DFF / 2, DFF}; S.init(2048, 2048, G, (int)blockIdx.x);
                  EpiPart E{P->out};
                  pg8::gemm_phase<EpiPart>(lds, g, S, E); }
                if (L + 1 < DEPTH && (int)blockIdx.x >= 64 && G > 64) {
                    const int tid_ = opaque_tid(); const int wave = __builtin_amdgcn_readfirstlane(tid_ >> 6), lane = tid_ & 63;
                    convert_layer_weights(lds, P, L + 1, ((int)blockIdx.x - 64) * 8 + wave, (G - 64) * 8, wave, lane);
                }
                xcd_barrier(gbar);
                combine_phase(P);
#endif
            }
        }
        }
#if !MK_MULTI
        if (ph + 1 < ph_hi) {
            if (ph == ph_lo) {
                asm volatile("s_waitcnt vmcnt(0)" ::: "memory"); __syncthreads();
                if (threadIdx.x == 0) { __builtin_amdgcn_fence(__ATOMIC_RELEASE, "agent"); asm volatile("s_waitcnt vmcnt(0)" ::: "memory"); }
                __syncthreads();
                cg::this_grid().sync();
                if (threadIdx.x == 0) { __builtin_amdgcn_fence(__ATOMIC_ACQUIRE, "agent"); asm volatile("s_waitcnt vmcnt(0)" ::: "memory"); }
                __syncthreads();
            } else xcd_barrier(gbar);
        }
#endif
    }
}

extern "C" void kernel_launch(void* const* d_in, const int* in_sizes, int n_in, void* d_out, int out_size, void* d_ws, size_t ws_size, hipStream_t stream) {
    static int grid = 0;
    if (grid == 0) {
        if (n_in != 31 || ws_size < WS_END) { fprintf(stderr, "kernel_launch: expected 31 inputs and >= %zu B of workspace (got %d, %zu)\n", (size_t)WS_END, n_in, ws_size); grid = -1; return; }
        if (hipFuncSetAttribute((const void*)mk_fwd, hipFuncAttributeMaxDynamicSharedMemorySize, LDS_BYTES) != hipSuccess) { fprintf(stderr, "kernel_launch: hipFuncSetAttribute failed\n"); grid = -1; return; }
        int dev = 0, cus = 0, per_cu = 0;
        hipGetDevice(&dev); hipDeviceGetAttribute(&cus, hipDeviceAttributeMultiprocessorCount, dev);
        hipOccupancyMaxActiveBlocksPerMultiprocessor(&per_cu, (const void*)mk_fwd, 512, LDS_BYTES);
        (void)hipGetLastError();
        grid = cus * (per_cu < 1 ? 1 : per_cu);
        if (grid > 256) grid = 256;
        if (grid < 128) { fprintf(stderr, "kernel_launch: grid %d too small for the mixer phase layout\n", grid); grid = -1; return; }
    }
    if (grid < 0) return;
#if !MK_MULTI
    if (hipMemsetAsync((char*)d_ws + WS_CTL, 0, CTL_ZERO_BYTES, stream) != hipSuccess) { fprintf(stderr, "kernel_launch: memset of the barrier words failed\n"); return; }
#endif
    Params p{};
    for (int i = 0; i < 31; ++i) p.in[i] = (const float*)d_in[i];
    p.out = (float*)d_out; p.ws = (unsigned char*)d_ws;
#if MK_MULTI
    for (int ph = 0; ph < NPH; ++ph) { p.ph_lo = ph; p.ph_hi = ph + 1; hipLaunchKernelGGL(mk_fwd, dim3(grid), dim3(512), LDS_BYTES, stream, p); }
#else
    p.ph_lo = 0; p.ph_hi = NPH;
    void* args[] = {&p};
    hipError_t e = hipLaunchCooperativeKernel((const void*)mk_fwd, dim3(grid), dim3(512), args, LDS_BYTES, stream);
    if (e != hipSuccess) fprintf(stderr, "kernel_launch: cooperative launch failed: %s (grid %d)\n", hipGetErrorString(e), grid);
#endif
}
```

```cpp
#include <hip/hip_runtime.h>
#include <hip/hip_cooperative_groups.h>
#include <cstdio>
#include <cstdint>
namespace cg = cooperative_groups;

#ifndef MK_MULTI
#define MK_MULTI 0
#endif

#ifndef PROBE_PRO
#define PROBE_PRO 0
#endif
#ifndef PROBE_M12
#define PROBE_M12 0
#endif
#ifndef REP_SUB
#define REP_SUB -1
#endif
#define LAS __attribute__((address_space(3)))
typedef unsigned short bf16_t;
typedef short bf16x8 __attribute__((ext_vector_type(8)));
typedef float f32x4 __attribute__((ext_vector_type(4)));
typedef float f32x2 __attribute__((ext_vector_type(2)));
typedef unsigned u32x4 __attribute__((ext_vector_type(4)));
typedef unsigned u32x2 __attribute__((ext_vector_type(2)));

constexpr int DM = 1024, MP = 32768, MTOT = 34816, DIN = 2816, DFF = 2816, DEPTH = 4;
constexpr int NSUB = 7, NPH = 2 + NSUB * DEPTH;
constexpr size_t O_PRET = 35651584, O_PSSM = 39845888, O_PLRU = 39976960, O_PCONV = 39993344;
constexpr size_t O_SRET = 40042496, O_SSSM = 48431104, O_SLRU = 48693248, O_SCONV = 48726016;
constexpr size_t MiB = 1u << 20;
constexpr size_t WS_ROT = 3 * MiB;
constexpr size_t WS_LAMB = 4 * MiB;
constexpr size_t WS_BB = 4 * MiB + 64 * 1024;
constexpr size_t WS_CP = 4 * MiB + 640 * 1024;
constexpr size_t WS_LRUW = 4 * MiB + 896 * 1024;
constexpr size_t WS_W = 6 * MiB;
constexpr size_t WL_IN = 0, WL_OUT = 5767168, WL_GU = WL_OUT + 2097152, WL_DN = WL_GU + 11534336, WL_GLU = WL_DN + 5767168, WL_STRIDE = WL_GLU + 262144;
constexpr size_t WS_XB = 104 * MiB, WS_MIXED = 172 * MiB, WS_Y = 240 * MiB, WS_PROJ = 258 * MiB;
constexpr size_t WS_SQMIX = 445 * MiB, WS_SQFFN = 446 * MiB, WS_GA = 447 * MiB, WS_GB = 448 * MiB, WS_GC = 449 * MiB;
constexpr size_t OUT_U = 0, OUT_CUMA = 32 * MiB  , WS_HLOC = 452 * MiB, WS_S5E = 488 * MiB  , WS_LSUM = 487 * MiB, WS_END = 492 * MiB;
static_assert(WS_W + 4 * WL_STRIDE <= WS_XB, "ws map");
__device__ __forceinline__ float sum4(const f32x4 v) { return (v[0] + v[1]) + (v[2] + v[3]); }

struct Params { const float* in[31]; float* out; unsigned char* ws; int ph_lo, ph_hi; };
typedef const __attribute__((address_space(4))) Params* KP;

__device__ __forceinline__ int opaque_tid() { int t = threadIdx.x; asm volatile("" : "+v"(t)); return t; }
__device__ __forceinline__ unsigned cvt_pk_bf16(float lo, float hi) { unsigned r; asm volatile("v_cvt_pk_bf16_f32 %0, %1, %2" : "=v"(r) : "v"(lo), "v"(hi)); return r; }
__device__ __forceinline__ bf16_t f2bf(float f) { return (bf16_t)(cvt_pk_bf16(f, 0.f) & 0xffffu); }
__device__ __forceinline__ float bf2f(bf16_t h) { return __builtin_bit_cast(float, (unsigned)h << 16); }
__device__ __forceinline__ float bflo(unsigned w) { return __builtin_bit_cast(float, w << 16); }
__device__ __forceinline__ float bfhi(unsigned w) { return __builtin_bit_cast(float, w & 0xffff0000u); }
__device__ __forceinline__ float sigmoidf_(float x) { return __builtin_amdgcn_rcpf(1.f + __expf(-x)); }
__device__ __forceinline__ float siluf_(float x) { return x * sigmoidf_(x); }
__device__ __forceinline__ float geluf_(float x) { return x * sigmoidf_(1.5957691216f * (x + 0.044715f * x * x * x)); }
__device__ __forceinline__ f32x4 mfma16(bf16x8 a, bf16x8 b, f32x4 c) { return __builtin_amdgcn_mfma_f32_16x16x32_bf16(a, b, c, 0, 0, 0); }

namespace pg8 {
constexpr int BM = 256, BK = 64, HALF = 128, HTB = HALF * BK * 2, STAGE_BYTES = 8 * HTB, NXCD = 8, WGM = 8;
__host__ __device__ __forceinline__ int lds_byte(int r, int c) { const int st = (r >> 4) * 2 + (c >> 5), rr = r & 15, cc = c & 31, ob = rr * 64 + cc * 2; return st * 1024 + (ob ^ (((ob >> 9) & 1) << 5)); }
__host__ __device__ __forceinline__ void stage_rc(int b, int& R, int& C) { const int st = b / 1024, sb = b % 1024, swz = sb ^ (((sb >> 9) & 1) << 5); R = (st >> 1) * 16 + swz / 64; C = (st & 1) * 32 + (swz % 64) / 2; }
__host__ __device__ __forceinline__ int perm32(int rho) { const int n = rho >> 4, i = rho & 15; return 8 * (i >> 2) + 4 * n + (i & 3); }
struct Unit { int pm, pn; };
struct Gemm { const bf16_t* A; const bf16_t* Bt; int M, N, K; int ld = 0; };
struct StaticOrder {
    int nM, nN, nwg, G, c;
    __device__ void init(int M, int N, int G_, int c_) { nM = M / BM; nN = N / BM; nwg = nM * nN; G = G_; c = c_; }
    __device__ bool next(int i, Unit& u) const {
        const long L = (long)i * G + c; if (L >= nwg) return false;
        int wgid = (int)L; { const int q = nwg / NXCD, r = nwg % NXCD, xcd = wgid % NXCD, off = wgid / NXCD; wgid = (xcd < r ? xcd * (q + 1) : r * (q + 1) + (xcd - r) * q) + off; }
        const int nig = WGM * nN, gid = wgid / nig, fm = gid * WGM, gsz = (nM - fm) < WGM ? (nM - fm) : WGM;
        u.pm = fm + ((wgid % nig) % gsz); u.pn = (wgid % nig) / gsz; return true;
    }
};
template <class Epi>
__device__ __forceinline__ void gemm_phase(LAS unsigned char* lds, const Gemm g, const StaticOrder& S, const Epi& E) {
    const int tid = opaque_tid(), wid = __builtin_amdgcn_readfirstlane(tid >> 6), lane = tid & 63, wr = wid >> 2, wc = wid & 3, fr = lane & 15, fq = lane >> 4;
    const int K = g.ld ? g.ld : g.K, nt = g.K / BK;
    unsigned voffA[2], voffB[2];
#pragma unroll
    for (int i = 0; i < 2; ++i) { int R, C; stage_rc(tid * 16 + i * 8192, R, C); const int Rb = Epi::PERM ? ((R & ~31) + perm32(R & 31)) : R;
        voffA[i] = (unsigned)(R * K + C) * 2u; voffB[i] = (unsigned)(Rb * K + C) * 2u; }
    const size_t kstep = (size_t)(BK * 2);
    const size_t hstep = (size_t)HALF * K * 2;
    const size_t tstep = 2 * hstep;
    const unsigned ldsw = (unsigned)wid * 1024u;
    const int aoff = lds_byte(wr * 64 + fr, fq * 8), boff = lds_byte(wc * 32 + fr, fq * 8);
#define PG8_SA(b, h) (((b) * 2 + (h)) * HTB)
#define PG8_SB(b, h) ((4 + (b) * 2 + (h)) * HTB)
#define PG8_STAGE(bufoff, gbase, voff) do { _Pragma("unroll") for (int _i = 0; _i < 2; ++_i) \
        __builtin_amdgcn_global_load_lds((const unsigned*)((const char*)(gbase) + (voff)[_i]), (LAS unsigned*)(lds + (bufoff) + ldsw + _i * 8192), 16, 0, 0); } while (0)
#define PG8_LDA(dst, b, h) do { _Pragma("unroll") for (int m = 0; m < 4; ++m) _Pragma("unroll") for (int k = 0; k < 2; ++k) dst[m][k] = *(const LAS bf16x8*)(lds + PG8_SA(b, h) + aoff + m * 2048 + k * 1024); } while (0)
#define PG8_LDB(dst, b, h) do { _Pragma("unroll") for (int n = 0; n < 2; ++n) _Pragma("unroll") for (int k = 0; k < 2; ++k) dst[n][k] = *(const LAS bf16x8*)(lds + PG8_SB(b, h) + boff + n * 2048 + k * 1024); } while (0)
#define PG8_MMA(ai, bj, At, Bt) do { __builtin_amdgcn_s_setprio(1); _Pragma("unroll") for (int m = 0; m < 4; ++m) _Pragma("unroll") for (int n = 0; n < 2; ++n) _Pragma("unroll") for (int k = 0; k < 2; ++k) \
        acc[ai][bj][m][n] = __builtin_amdgcn_mfma_f32_16x16x32_bf16(Bt[n][k], At[m][k], acc[ai][bj][m][n], 0, 0, 0); __builtin_amdgcn_s_setprio(0); } while (0)
#define PG8_WAIT_V(n) asm volatile("s_waitcnt vmcnt(" #n ")" ::: "memory")
#define PG8_WAIT_L(n) asm volatile("s_waitcnt lgkmcnt(" #n ")" ::: "memory")
#define PG8_BAR __builtin_amdgcn_s_barrier()
#define PG8_SCHED __builtin_amdgcn_sched_barrier(0)
    Unit cur, nxt; int ui = 0;
    if (!S.next(0, cur)) return;
    f32x4 acc[2][2][4][2];
#pragma unroll
    for (int a = 0; a < 2; ++a)
#pragma unroll
        for (int b = 0; b < 2; ++b)
#pragma unroll
            for (int m = 0; m < 4; ++m)
#pragma unroll
                for (int n = 0; n < 2; ++n) acc[a][b][m][n] = (f32x4){0.f, 0.f, 0.f, 0.f};
    bf16x8 At[4][2], B0[2][2], B1[2][2];
    const size_t kh = (size_t)g.K * 2;
    const char* cA = (const char*)g.A + (size_t)cur.pm * tstep + (Epi::SPLITK ? (size_t)(cur.pn >> 2) * kh : 0); const char* cB = (const char*)g.Bt + (size_t)(Epi::SPLITK ? (cur.pn & 3) : cur.pn) * tstep + (Epi::SPLITK ? (size_t)(cur.pn >> 2) * kh : 0);
    PG8_STAGE(PG8_SB(0, 0), cB, voffB); PG8_STAGE(PG8_SB(0, 1), cB + hstep, voffB); PG8_STAGE(PG8_SA(0, 0), cA, voffA); PG8_STAGE(PG8_SA(0, 1), cA + hstep, voffA);
    if (wr == 1) PG8_BAR;
    PG8_WAIT_V(2); PG8_BAR;
    PG8_STAGE(PG8_SB(1, 0), cB + kstep, voffB); PG8_STAGE(PG8_SA(1, 0), cA + kstep, voffA); PG8_STAGE(PG8_SB(1, 1), cB + hstep + kstep, voffB);
    PG8_WAIT_V(6); PG8_BAR;
    for (;;) {
        const bool has_next = S.next(ui + 1, nxt);
        const char* nA = has_next ? (const char*)g.A + (size_t)nxt.pm * tstep + (Epi::SPLITK ? (size_t)(nxt.pn >> 2) * kh : 0) : cA; const char* nB = has_next ? (const char*)g.Bt + (size_t)(Epi::SPLITK ? (nxt.pn & 3) : nxt.pn) * tstep + (Epi::SPLITK ? (size_t)(nxt.pn >> 2) * kh : 0) : cB;
#pragma unroll 1
        for (int t = 0; t < nt; t += 2) {
            const bool last = (t == nt - 2);
            const char* a1 = cA + (size_t)(t + 1) * kstep;
            const char* a2 = last ? nA : cA + (size_t)(t + 2) * kstep; const char* b2 = last ? nB : cB + (size_t)(t + 2) * kstep;
            const char* a3 = a2 + kstep; const char* b3 = b2 + kstep;
            if constexpr (Epi::HOOK) { E.khook(acc, t, cur, wr, fr); PG8_SCHED; }
            PG8_LDB(B0, 0, 0); PG8_LDB(B1, 0, 1); PG8_SCHED; PG8_LDA(At, 0, 0); PG8_STAGE(PG8_SA(1, 1), a1 + hstep, voffA);
            PG8_WAIT_V(8); PG8_WAIT_L(0); PG8_BAR; PG8_MMA(0, 0, At, B0); PG8_MMA(0, 1, At, B1); PG8_BAR; PG8_SCHED;
            PG8_LDA(At, 0, 1); PG8_STAGE(PG8_SB(0, 0), b2, voffB); PG8_STAGE(PG8_SB(0, 1), b2 + hstep, voffB); PG8_STAGE(PG8_SA(0, 0), a2, voffA);
            PG8_WAIT_V(8); PG8_WAIT_L(0); PG8_BAR; PG8_MMA(1, 0, At, B0); PG8_MMA(1, 1, At, B1); PG8_BAR; PG8_SCHED;
            PG8_LDB(B0, 1, 0); PG8_LDB(B1, 1, 1); PG8_SCHED; PG8_LDA(At, 1, 0); PG8_STAGE(PG8_SA(0, 1), a2 + hstep, voffA);
            PG8_WAIT_V(8); PG8_WAIT_L(0); PG8_BAR; PG8_MMA(0, 0, At, B0); PG8_MMA(0, 1, At, B1); PG8_BAR; PG8_SCHED;
            PG8_LDA(At, 1, 1); PG8_STAGE(PG8_SB(1, 0), b3, voffB); PG8_STAGE(PG8_SB(1, 1), b3 + hstep, voffB); PG8_STAGE(PG8_SA(1, 0), a3, voffA);
            PG8_WAIT_V(8); PG8_WAIT_L(0); PG8_BAR; PG8_MMA(1, 0, At, B0); PG8_MMA(1, 1, At, B1); PG8_BAR; PG8_SCHED;
        }
        if (wr == 0) PG8_BAR;
        E(acc, cur, wr, wc, fr, fq);
        if (!has_next) break;
#pragma unroll
        for (int a = 0; a < 2; ++a)
#pragma unroll
            for (int b = 0; b < 2; ++b)
#pragma unroll
                for (int m = 0; m < 4; ++m)
#pragma unroll
                    for (int n = 0; n < 2; ++n) acc[a][b][m][n] = (f32x4){0.f, 0.f, 0.f, 0.f};
        cur = nxt; cA = nA; cB = nB; ++ui;
        if (wr == 1) PG8_BAR;
    }
    PG8_WAIT_V(0);
    PG8_BAR;
#undef PG8_SA
#undef PG8_SB
#undef PG8_STAGE
#undef PG8_LDA
#undef PG8_LDB
#undef PG8_MMA
#undef PG8_WAIT_V
#undef PG8_WAIT_L
#undef PG8_BAR
#undef PG8_SCHED
}
}
using pg8::Unit;
typedef f32x4 Acc[2][2][4][2];

struct EpiProj {
    static constexpr bool PERM = true, HOOK = false, SPLITK = false;
    bf16_t* O; const f32x4* sq; const f32x4* rot;
    __device__ __forceinline__ void operator()(const Acc& acc, const Unit& u, int wr, int wc, int fr, int fq) const {
        const int row0 = u.pm * 256 + wr * 64 + fr, pn = u.pn;
        if (pn < 4) {
            const float qs = (pn < 2) ? 0.08838834764831845f : 1.f;
            const int idx0 = 32 * (wc & 1) + 8 * fq;
            const int lcol = 256 * pn + 128 * (wc >> 1) + idx0;
#pragma unroll
            for (int ai = 0; ai < 2; ++ai)
#pragma unroll
                for (int m = 0; m < 4; ++m) {
                    const int row = row0 + ai * 128 + m * 16;
                    const float rs = rsqrtf(sum4(sq[row]) * (1.f / 1024.f) + 1e-6f) * qs;
                    const int pos = row < MP ? (row & 2047) : 1024 + ((row - MP) & 63);
                    const f32x4* rp = rot + pos * 32 + (idx0 >> 1);
                    const f32x4 c0 = rp[0], c1 = rp[1], c2 = rp[2], c3 = rp[3];
                    const f32x4 a0 = acc[ai][0][m][0] * rs, a1 = acc[ai][0][m][1] * rs, b0 = acc[ai][1][m][0] * rs, b1 = acc[ai][1][m][1] * rs;
                    u32x4 w1, w2;
                    w1.x = cvt_pk_bf16(a0[0] * c0[0] - b0[0] * c0[1], a0[1] * c0[2] - b0[1] * c0[3]);
                    w1.y = cvt_pk_bf16(a0[2] * c1[0] - b0[2] * c1[1], a0[3] * c1[2] - b0[3] * c1[3]);
                    w1.z = cvt_pk_bf16(a1[0] * c2[0] - b1[0] * c2[1], a1[1] * c2[2] - b1[1] * c2[3]);
                    w1.w = cvt_pk_bf16(a1[2] * c3[0] - b1[2] * c3[1], a1[3] * c3[2] - b1[3] * c3[3]);
                    w2.x = cvt_pk_bf16(b0[0] * c0[0] + a0[0] * c0[1], b0[1] * c0[2] + a0[1] * c0[3]);
                    w2.y = cvt_pk_bf16(b0[2] * c1[0] + a0[2] * c1[1], b0[3] * c1[2] + a0[3] * c1[3]);
                    w2.z = cvt_pk_bf16(b1[0] * c2[0] + a1[0] * c2[1], b1[1] * c2[2] + a1[1] * c2[3]);
                    w2.w = cvt_pk_bf16(b1[2] * c3[0] + a1[2] * c3[1], b1[3] * c3[2] + a1[3] * c3[3]);
                    bf16_t* op = O + (size_t)row * DIN + lcol;
                    *(u32x4*)op = w1; *(u32x4*)(op + 64) = w2;
                }
        } else {
            const int col0 = 256 * pn + 32 * wc + 8 * fq;
#pragma unroll
            for (int ai = 0; ai < 2; ++ai)
#pragma unroll
                for (int m = 0; m < 4; ++m) {
                    const int row = row0 + ai * 128 + m * 16;
                    const float rs = rsqrtf(sum4(sq[row]) * (1.f / 1024.f) + 1e-6f);
                    bf16_t* op = O + (size_t)row * DIN + col0;
#pragma unroll
                    for (int bj = 0; bj < 2; ++bj) { const f32x4 v0 = acc[ai][bj][m][0] * rs, v1 = acc[ai][bj][m][1] * rs; u32x4 w;
                        w.x = cvt_pk_bf16(v0[0], v0[1]); w.y = cvt_pk_bf16(v0[2], v0[3]); w.z = cvt_pk_bf16(v1[0], v1[1]); w.w = cvt_pk_bf16(v1[2], v1[3]);
                        *(u32x4*)(op + bj * 128) = w; }
                }
        }
    }
};
template <bool GRP> struct EpiRes {
    static constexpr bool PERM = false, HOOK = GRP, SPLITK = false;
    float* X  ; bf16_t* XB  ; float* sqn; const f32x4* gA; const f32x2* gB; const float* gC; LAS float* part;
    __device__ __forceinline__ float gcsum(unsigned row) const { return gC[row]; }
    __device__ __forceinline__ void khook(Acc& acc, int t, const Unit& u, int wr, int fr) const {
        if (t == 8 || t == 12) {
            asm volatile("" : "+v"(fr));
#pragma unroll
            for (int ai = 0; ai < 2; ++ai)
#pragma unroll
                for (int m = 0; m < 4; ++m) {
                    const unsigned row = (unsigned)(u.pm * 256 + ai * 128 + wr * 64 + m * 16 + fr);
                    const f32x2 gb = gB[row]; const float sB = (gb[0] + gb[1]) * (1.f / 256.f) + 1e-6f;
                    float ratio;
                    if (t == 8) ratio = sqrtf(sB / (sum4(gA[row]) * (1.f / 512.f) + 1e-6f));
                    else ratio = sqrtf((gcsum(row) * (1.f / 256.f) + 1e-6f) / sB);
                    asm volatile("" ::: "memory");
#pragma unroll
                    for (int bj = 0; bj < 2; ++bj)
#pragma unroll
                        for (int n = 0; n < 2; ++n) acc[ai][bj][m][n] *= ratio;
                }
        }
    }
    __device__ __forceinline__ void operator()(const Acc& acc, const Unit& u, int wr, int wc, int fr, int fq) const {
        const int row0 = u.pm * 256 + wr * 64 + fr, col0 = u.pn * 256 + wc * 32 + 4 * fq;
#pragma unroll
        for (int ai = 0; ai < 2; ++ai)
#pragma unroll
            for (int m = 0; m < 4; ++m) {
                const int row = row0 + ai * 128 + m * 16;
                float sc = 1.f; if (GRP) sc = rsqrtf(gcsum((unsigned)row) * (1.f / 256.f) + 1e-6f);
                const unsigned off = (unsigned)row * DM + col0; float ss = 0.f;
#pragma unroll
                for (int bj = 0; bj < 2; ++bj)
#pragma unroll
                    for (int n = 0; n < 2; ++n) {
                        const u32x2 xr = *(const u32x2*)(XB + off + bj * 128 + n * 16);
                        const f32x4 xo = (f32x4){bflo(xr[0]), bfhi(xr[0]), bflo(xr[1]), bfhi(xr[1])};
                        const f32x4 xn = xo + acc[ai][bj][m][n] * sc;
                        if (X) *(f32x4*)(X + off + bj * 128 + n * 16) = xn;
                        u32x2 w; w.x = cvt_pk_bf16(xn[0], xn[1]); w.y = cvt_pk_bf16(xn[2], xn[3]);
                        *(u32x2*)(XB + off + bj * 128 + n * 16) = w;
                        ss += (xn[0] * xn[0] + xn[1] * xn[1]) + (xn[2] * xn[2] + xn[3] * xn[3]);
                    }
                ss += __shfl_xor(ss, 16); ss += __shfl_xor(ss, 32);
                if (fq == 0) part[wc * 256 + ai * 128 + wr * 64 + m * 16 + fr] = ss;
                asm volatile("" ::: "memory");
            }
        asm volatile("s_waitcnt lgkmcnt(0)" ::: "memory"); __builtin_amdgcn_s_barrier(); asm volatile("" ::: "memory");
        { const int t_ = (wr * 4 + wc) * 64 + fq * 16 + fr;
          if (t_ < 256) sqn[(size_t)(u.pm * 256 + t_) * 4 + u.pn] = (part[t_] + part[256 + t_]) + (part[512 + t_] + part[768 + t_]); }
        asm volatile("s_waitcnt lgkmcnt(0)" ::: "memory"); __builtin_amdgcn_s_barrier(); asm volatile("" ::: "memory");
    }
};
struct EpiPart {
    static constexpr bool PERM = false, HOOK = false, SPLITK = true;
    float* PART;
    __device__ __forceinline__ void operator()(const Acc& acc, const Unit& u, int wr, int wc, int fr, int fq) const {
        float* base = PART + (size_t)((u.pn >> 2) * 32 + u.pm * 4 + (u.pn & 3)) * 65536 + (wr * 64 + fr) * 256 + wc * 32 + 4 * fq;
#pragma unroll
        for (int ai = 0; ai < 2; ++ai)
#pragma unroll
            for (int m = 0; m < 4; ++m)
#pragma unroll
                for (int bj = 0; bj < 2; ++bj)
#pragma unroll
                    for (int n = 0; n < 2; ++n) *(f32x4*)(base + (ai * 128 + m * 16) * 256 + bj * 128 + n * 16) = acc[ai][bj][m][n];
    }
};
struct EpiSwiGLU {
    static constexpr bool PERM = true, HOOK = false, SPLITK = false;
    bf16_t* O; const f32x4* sq;
    __device__ __forceinline__ void operator()(const Acc& acc, const Unit& u, int wr, int wc, int fr, int fq) const {
        const int row0 = u.pm * 256 + wr * 64 + fr, col0 = 128 * u.pn + 32 * wc + 8 * fq;
#pragma unroll
        for (int ai = 0; ai < 2; ++ai)
#pragma unroll
            for (int m = 0; m < 4; ++m) {
                const int row = row0 + ai * 128 + m * 16;
                const float rs = rsqrtf(sum4(sq[row]) * (1.f / 1024.f) + 1e-6f);
                float o[8];
#pragma unroll
                for (int n = 0; n < 2; ++n)
#pragma unroll
                    for (int i = 0; i < 4; ++i) { const float gt = acc[ai][0][m][n][i] * rs, up = acc[ai][1][m][n][i] * rs; o[4 * n + i] = siluf_(gt) * up; }
                u32x4 w; w.x = cvt_pk_bf16(o[0], o[1]); w.y = cvt_pk_bf16(o[2], o[3]); w.z = cvt_pk_bf16(o[4], o[5]); w.w = cvt_pk_bf16(o[6], o[7]);
                *(u32x4*)(O + (size_t)row * DFF + col0) = w;
            }
    }
};
struct EpiGLU {
    static constexpr bool PERM = true, HOOK = false, SPLITK = false;
    bf16_t* O; float* gB; LAS float* part;
    __device__ __forceinline__ void operator()(const Acc& acc, const Unit& u, int wr, int wc, int fr, int fq) const {
        const int row0 = u.pm * 256 + wr * 64 + fr, col0 = 512 + 128 * u.pn + 32 * wc + 8 * fq;
#pragma unroll
        for (int ai = 0; ai < 2; ++ai)
#pragma unroll
            for (int m = 0; m < 4; ++m) {
                const int row = row0 + ai * 128 + m * 16;
                float o[8]; float ss = 0.f;
#pragma unroll
                for (int n = 0; n < 2; ++n)
#pragma unroll
                    for (int i = 0; i < 4; ++i) { const float v = acc[ai][0][m][n][i] * sigmoidf_(acc[ai][1][m][n][i]); o[4 * n + i] = v; ss += v * v; }
                u32x4 w; w.x = cvt_pk_bf16(o[0], o[1]); w.y = cvt_pk_bf16(o[2], o[3]); w.z = cvt_pk_bf16(o[4], o[5]); w.w = cvt_pk_bf16(o[6], o[7]);
                *(u32x4*)(O + (size_t)row * DM + col0) = w;
                ss += __shfl_xor(ss, 16); ss += __shfl_xor(ss, 32);
                if (fq == 0) part[wc * 256 + ai * 128 + wr * 64 + m * 16 + fr] = ss;
            }
        asm volatile("s_waitcnt lgkmcnt(0)" ::: "memory"); __builtin_amdgcn_s_barrier(); asm volatile("" ::: "memory");
        { const int t_ = (wr * 4 + wc) * 64 + fq * 16 + fr;
          if (t_ < 256) gB[(size_t)(u.pm * 256 + t_) * 2 + u.pn] = (part[t_] + part[256 + t_]) + (part[512 + t_] + part[768 + t_]); }
        asm volatile("s_waitcnt lgkmcnt(0)" ::: "memory"); __builtin_amdgcn_s_barrier(); asm volatile("" ::: "memory");
    }
};

__device__ __forceinline__ float wave_sum(float v) {
#pragma unroll
    for (int o = 1; o < 64; o <<= 1) v += __shfl_xor(v, o);
    return v;
}
__device__ __forceinline__ void tr_item(const float* W, int ldw, int srccol0, const float* gain, bf16_t* WT, int K, int drow0, int k0, LAS float* scr, int lane) {
    { const int r8 = lane >> 3, c4 = (lane & 7) * 4;
#pragma unroll
      for (int i = 0; i < 8; ++i) { const int kk = 8 * i + r8; f32x4 v = *(const f32x4*)(W + (size_t)(k0 + kk) * ldw + srccol0 + c4); if (gain) v *= gain[k0 + kk];
          scr[kk * 33 + c4] = v[0]; scr[kk * 33 + c4 + 1] = v[1]; scr[kk * 33 + c4 + 2] = v[2]; scr[kk * 33 + c4 + 3] = v[3]; } }
    asm volatile("s_waitcnt lgkmcnt(0)" ::: "memory");
    const int c = lane & 7;
#pragma unroll
    for (int j = 0; j < 4; ++j) { const int n = (lane >> 3) + 8 * j; const LAS float* s = scr + (8 * c) * 33 + n;
        u32x4 o; o.x = cvt_pk_bf16(s[0 * 33], s[1 * 33]); o.y = cvt_pk_bf16(s[2 * 33], s[3 * 33]); o.z = cvt_pk_bf16(s[4 * 33], s[5 * 33]); o.w = cvt_pk_bf16(s[6 * 33], s[7 * 33]);
        *(u32x4*)(WT + (size_t)(drow0 + n) * K + k0 + 8 * c) = o; }
    asm volatile("s_waitcnt lgkmcnt(0)" ::: "memory");
}
__device__ __forceinline__ void convert_layer_weights(LAS unsigned char* lds, KP P, int L, int first, int stride, int wave, int lane) {
    unsigned char* ws = P->ws;
    LAS float* scr = (LAS float*)(lds + wave * 16384);
    constexpr int I_IN = 16 * 88, I_OUT = 16 * 32, I_GU = 16 * 176, I_DN = 44 * 32, I_GLU = 4 * 16, I_L = I_IN + I_OUT + I_GU + I_DN + I_GLU;
    unsigned char* wl = ws + WS_W + (size_t)L * WL_STRIDE;
    for (int it = first; it < I_L; it += stride) {
        int r = it;
        if (r < I_IN) { const int kb = r / 88, d = (r % 88) * 32; int sc0 = d;
            if (d < 1024) { const int pn = d >> 8, pc = d & 255, wcc = (pc >> 5) & 3, bj = pc >> 7; sc0 = 256 * pn + 128 * (wcc >> 1) + 64 * bj + 32 * (wcc & 1); }
            tr_item(P->in[7] + (size_t)L * DM * DIN, DIN, sc0, P->in[6] + L * DM, (bf16_t*)(wl + WL_IN), DM, d, 64 * kb, scr, lane); continue; }
        r -= I_IN;
        if (r < I_OUT) { const int kb = r / 32, d = (r % 32) * 32;
            tr_item(P->in[9] + (size_t)L * DM * DM, DM, d, P->in[8] + L * DM, (bf16_t*)(wl + WL_OUT), DM, d, 64 * kb, scr, lane); continue; }
        r -= I_OUT;
        if (r < I_GU) { const int kb = r / 176, d = (r % 176) * 32; const int pn = d >> 8, pc = d & 255, bj = pc >> 7; const int ch0 = 128 * pn + (pc & 127);
            tr_item((bj ? P->in[28] : P->in[27]) + (size_t)L * DM * DFF, DFF, ch0, P->in[26] + L * DM, (bf16_t*)(wl + WL_GU), DM, d, 64 * kb, scr, lane); continue; }
        r -= I_GU;
        if (r < I_DN) { const int kb = r / 32, d = (r % 32) * 32;
            tr_item(P->in[29] + (size_t)L * DFF * DM, DM, d, nullptr, (bf16_t*)(wl + WL_DN), DFF, d, 64 * kb, scr, lane); continue; }
        r -= I_DN;
        { const int kb = r / 16, d = (r % 16) * 32; const int pn = d >> 8, pc = d & 255, bj = pc >> 7; const int sc0 = 256 * bj + 128 * pn + (pc & 127);
            tr_item(P->in[18] + (size_t)L * 256 * 512, 512, sc0, nullptr, (bf16_t*)(wl + WL_GLU), 256, d, 64 * kb, scr, lane); }
    }
}
__device__ __forceinline__ void prologue(LAS unsigned char* lds, KP P) {
    const int tid = opaque_tid(), lane = tid & 63, wave = __builtin_amdgcn_readfirstlane(tid >> 6);
    const int G = gridDim.x, gw = blockIdx.x * 8 + wave, NGW = G * 8;
    const int gt = blockIdx.x * 512 + tid, NGT = G * 512;
    unsigned char* ws = P->ws;
    convert_layer_weights(lds, P, 0, gw, NGW, wave, lane);
    { bf16_t* o = (bf16_t*)(ws + WS_LRUW);
      for (int e = gt; e < DEPTH * 4 * 128 * 64; e += NGT) { const int L = e >> 15, hb = (e >> 13) & 3, n = (e >> 6) & 127, i = e & 63;
          const float* src = (n < 64) ? P->in[21] : P->in[23]; o[e] = f2bf(src[(((size_t)L * 4 + hb) * 64 + i) * 64 + (n & 63)]); } }
    for (int e = gt; e < DEPTH * 16 * 64; e += NGT) {
        const int L = e >> 10, g = (e >> 6) & 15, p = e & 63;
        const float are = P->in[10][e], aim = P->in[11][e];
        const float dt = __expf(P->in[17][L * 16 + g]);
        const float mag = expf(are * dt); float ang = aim * dt; const float rev = ang * 0.15915494309189535f; ang = (rev - rintf(rev)) * 6.283185307179586f;
        const float lr = mag * cosf(ang), li = mag * sinf(ang);
        ((f32x2*)(ws + WS_LAMB))[e] = (f32x2){lr, li};
        const float nr = lr - 1.f, ni = li, den = 1.f / (are * are + aim * aim);
        const float cr = (nr * are + ni * aim) * den, ci = (ni * are - nr * aim) * den;
        bf16_t* bb = (bf16_t*)(ws + WS_BB) + ((size_t)(L * 16 + g) * 128) * 32;
        const float* bre = P->in[12] + (size_t)e * 16; const float* bim = P->in[13] + (size_t)e * 16;
        for (int j = 0; j < 16; ++j) { const float br = bre[j], bi = bim[j]; bb[p * 32 + j] = f2bf(cr * br - ci * bi); bb[(64 + p) * 32 + j] = f2bf(cr * bi + ci * br); bb[p * 32 + 16 + j] = 0; bb[(64 + p) * 32 + 16 + j] = 0; }
        bf16_t* cp = (bf16_t*)(ws + WS_CP) + ((size_t)(L * 16 + g) * 16) * 128;
        const float* cre = P->in[14] + ((size_t)(L * 16 + g) * 16) * 64; const float* cim = P->in[15] + ((size_t)(L * 16 + g) * 16) * 64;
        for (int c = 0; c < 16; ++c) { cp[c * 128 + p] = f2bf(cre[c * 64 + p]); cp[c * 128 + 64 + p] = f2bf(-cim[c * 64 + p]); }
    }
    for (int e = gt; e < 2048 * 64; e += NGT) { const int pos = e >> 6, idx = e & 63;
        const float inv = exp2f(-(float)idx * (13.287712379549449f / 64.f)); const float ang = (float)pos * inv;
        const double rev = (double)ang * 0.15915494309189535; const float fr_ = (float)(rev - rint(rev)) * 6.283185307179586f;
        ((f32x2*)(ws + WS_ROT))[e] = (f32x2){cosf(fr_), sinf(fr_)}; }
    { bf16_t* XB = (bf16_t*)(ws + WS_XB); f32x4* sq0 = (f32x4*)(ws + WS_SQMIX);
      for (int m = gw; m < MTOT; m += NGW) {
          const float* xr = (m < MP) ? P->in[0] + (size_t)m * DM : P->in[1] + (size_t)(m - MP) * DM;
          float s = 0.f;
#pragma unroll
          for (int j = 0; j < 4; ++j) { const f32x4 v = ((const f32x4*)xr)[lane + 64 * j]; s += (v[0] * v[0] + v[1] * v[1]) + (v[2] * v[2] + v[3] * v[3]);
              u32x2 w; w.x = cvt_pk_bf16(v[0], v[1]); w.y = cvt_pk_bf16(v[2], v[3]); ((u32x2*)(XB + (size_t)m * DM))[lane + 64 * j] = w; }
          s = wave_sum(s); if (lane == 0) sq0[m] = (f32x4){s, 0.f, 0.f, 0.f}; } }
}

constexpr int R_QS = 0, R_KS = 17408, R_KT = 34816, R_VT = 53248, R_PS = 71680, R_ST = 80896, R_RED = 115712, R_RED2 = 116736;
__device__ __forceinline__ void ret_stage_kv(LAS unsigned char* lds, const u32x4 (&gk)[2], const u32x4 (&gv)[2], int lj, int lc, float kd) {
#pragma unroll
    for (int i = 0; i < 2; ++i) {
        const int c8 = lc + 8 * i;
#pragma unroll
        for (int x = 0; x < 4; ++x) {
            const unsigned kw = gk[i][x], vw = gv[i][x];
            const unsigned kp = cvt_pk_bf16(bflo(kw) * kd, bfhi(kw) * kd);
            *(LAS bf16_t*)(lds + R_KT + (8 * c8 + 2 * x) * 144 + lj * 2) = (bf16_t)(kp & 0xffffu);
            *(LAS bf16_t*)(lds + R_KT + (8 * c8 + 2 * x + 1) * 144 + lj * 2) = (bf16_t)(kp >> 16);
            *(LAS bf16_t*)(lds + R_VT + (8 * c8 + 2 * x) * 144 + lj * 2) = (bf16_t)(vw & 0xffffu);
            *(LAS bf16_t*)(lds + R_VT + (8 * c8 + 2 * x + 1) * 144 + lj * 2) = (bf16_t)(vw >> 16);
        }
    }
}
__device__ __forceinline__ void ret_state_update(LAS unsigned char* lds, f32x4 (&S)[8], int wid, int fr, int fq, float g64) {
    bf16x8 kf[2];
#pragma unroll
    for (int ks = 0; ks < 2; ++ks) kf[ks] = *(const LAS bf16x8*)(lds + R_KT + (16 * wid + fr) * 144 + (32 * ks + 8 * fq) * 2);
#pragma unroll
    for (int tv = 0; tv < 8; ++tv) { S[tv] *= g64;
#pragma unroll
        for (int ks = 0; ks < 2; ++ks) { const bf16x8 vf = *(const LAS bf16x8*)(lds + R_VT + (16 * tv + fr) * 144 + (32 * ks + 8 * fq) * 2); S[tv] = mfma16(kf[ks], vf, S[tv]); } }
}
constexpr int RSEG_N = 6;
__device__ __forceinline__ int rseg_start(int seg) { return seg < 2 ? 6 * seg : 12 + 5 * (seg - 2); }
__device__ __forceinline__ int rseg_len(int seg) { return seg < 2 ? 6 : 5; }
__device__ __forceinline__ void ret_pass1(LAS unsigned char* lds, KP P, int L, int s, int h, int seg) {
    const int tid = opaque_tid(), wid = __builtin_amdgcn_readfirstlane(tid >> 6), lane = tid & 63, fr = lane & 15, fq = lane >> 4;
    const int R0 = s * 2048 + 64 * rseg_start(seg), nch1 = rseg_len(seg);
    const float log2g = log2f(1.f - exp2f(-5.f - (float)h));
    const bf16_t* PROJ = (const bf16_t*)(P->ws + WS_PROJ);
    f32x4 S[8];
#pragma unroll
    for (int tv = 0; tv < 8; ++tv) S[tv] = (f32x4){0.f, 0.f, 0.f, 0.f};
    const int lj = tid & 63, lc = tid >> 6;
    u32x4 gk[2], gv[2];
    { const bf16_t* rp = PROJ + (size_t)(R0 + lj) * DIN + 128 * h + 8 * lc;
#pragma unroll
      for (int i = 0; i < 2; ++i) { gk[i] = *(const u32x4*)(rp + 512 + 64 * i); gv[i] = *(const u32x4*)(rp + 1024 + 64 * i); } }
    const float g64 = exp2f(log2g * 64.f), kd = exp2f(log2g * (float)(63 - lj));
    for (int c = 0; c < nch1; ++c) {
        __syncthreads();
        ret_stage_kv(lds, gk, gv, lj, lc, kd);
        __syncthreads();
        if (c + 1 < nch1) { const bf16_t* rp = PROJ + (size_t)(R0 + 64 * (c + 1) + lj) * DIN + 128 * h + 8 * lc;
#pragma unroll
            for (int i = 0; i < 2; ++i) { gk[i] = *(const u32x4*)(rp + 512 + 64 * i); gv[i] = *(const u32x4*)(rp + 1024 + 64 * i); } }
        ret_state_update(lds, S, wid, fr, fq, g64);
    }
    float* U = (float*)((unsigned char*)P->out + OUT_U) + (size_t)((s * 4 + h) * 8 + seg) * 16384;
#pragma unroll
    for (int tv = 0; tv < 8; ++tv)
#pragma unroll
        for (int jj = 0; jj < 4; ++jj) U[(tv * 4 + jj) * 512 + tid] = S[tv][jj];
}
__device__ __forceinline__ void ret_item(LAS unsigned char* lds, KP P, int L, int s, int h, int seg) {
    const int tid = opaque_tid(), wid = __builtin_amdgcn_readfirstlane(tid >> 6), lane = tid & 63, fr = lane & 15, fq = lane >> 4;
    const bool prompt = s < 16;
    const int R0 = prompt ? s * 2048 + 64 * rseg_start(seg) : MP + (s - 16) * 64, nch = prompt ? rseg_len(seg) : 1;
    const float log2g = log2f(1.f - exp2f(-5.f - (float)h));
    const bf16_t* PROJ = (const bf16_t*)(P->ws + WS_PROJ);
    bf16_t* MIXED = (bf16_t*)(P->ws + WS_MIXED);
    float* gA = (float*)(P->ws + WS_GA);
    f32x4 S[8];
#pragma unroll
    for (int tv = 0; tv < 8; ++tv) S[tv] = (f32x4){0.f, 0.f, 0.f, 0.f};
    if (prompt) {
        const float* U = (const float*)((unsigned char*)P->out + OUT_U) + (size_t)((s * 4 + h) * 8) * 16384 + tid;
        float un[32];
        if (seg > 0) {
#pragma unroll
            for (int e = 0; e < 32; ++e) un[e] = U[e * 512];
        }
        for (int w = 0; w < seg; ++w) {
            const float pw = exp2f(log2g * 64.f * (float)(rseg_start(seg) - rseg_start(w + 1)));
            float uc[32];
#pragma unroll
            for (int e = 0; e < 32; ++e) uc[e] = un[e];
            if (w + 1 < seg) {
#pragma unroll
                for (int e = 0; e < 32; ++e) un[e] = U[(size_t)(w + 1) * 16384 + e * 512];
            }
#pragma unroll
            for (int tv = 0; tv < 8; ++tv)
#pragma unroll
                for (int jj = 0; jj < 4; ++jj) S[tv][jj] += pw * uc[tv * 4 + jj];
        }
    } else {
        const float* sp = P->in[2] + ((size_t)(L * 32 + (s - 16)) * 4 + h) * 16384;
#pragma unroll
        for (int tv = 0; tv < 8; ++tv)
#pragma unroll
            for (int jj = 0; jj < 4; ++jj) S[tv][jj] = sp[(16 * wid + 4 * fq + jj) * 128 + 16 * tv + fr];
    }
    const int lj = tid & 63, lc = tid >> 6;
    u32x4 gq[2], gk[2], gv[2];
    { const bf16_t* rp = PROJ + (size_t)(R0 + lj) * DIN + 128 * h + 8 * lc;
#pragma unroll
      for (int i = 0; i < 2; ++i) { gq[i] = *(const u32x4*)(rp + 64 * i); gk[i] = *(const u32x4*)(rp + 512 + 64 * i); gv[i] = *(const u32x4*)(rp + 1024 + 64 * i); } }
    const float g64 = exp2f(log2g * 64.f), kd = exp2f(log2g * (float)(63 - lj));
    for (int c = 0; c < nch; ++c) {
        __syncthreads();
        {
#pragma unroll
            for (int i = 0; i < 2; ++i) {
                const int c8 = lc + 8 * i;
                *(LAS u32x4*)(lds + R_QS + lj * 272 + c8 * 16) = gq[i];
                *(LAS u32x4*)(lds + R_KS + lj * 272 + c8 * 16) = gk[i];
            }
            ret_stage_kv(lds, gk, gv, lj, lc, kd);
#pragma unroll
            for (int tv = 0; tv < 8; ++tv) { u32x2 w; w.x = cvt_pk_bf16(S[tv][0], S[tv][1]); w.y = cvt_pk_bf16(S[tv][2], S[tv][3]);
                *(LAS u32x2*)(lds + R_ST + (16 * tv + fr) * 272 + (16 * wid + 4 * fq) * 2) = w; }
        }
        __syncthreads();
        if (c + 1 < nch) { const bf16_t* rp = PROJ + (size_t)(R0 + 64 * (c + 1) + lj) * DIN + 128 * h + 8 * lc;
#pragma unroll
            for (int i = 0; i < 2; ++i) { gq[i] = *(const u32x4*)(rp + 64 * i); gk[i] = *(const u32x4*)(rp + 512 + 64 * i); gv[i] = *(const u32x4*)(rp + 1024 + 64 * i); } }
        const int ti = wid >> 1;
        bf16x8 qfr[4];
        {
            const int tj0 = 2 * (wid & 1);
            f32x4 sc[2] = {(f32x4){0.f, 0.f, 0.f, 0.f}, (f32x4){0.f, 0.f, 0.f, 0.f}};
#pragma unroll
            for (int ks = 0; ks < 4; ++ks) { const bf16x8 qf = qfr[ks] = *(const LAS bf16x8*)(lds + R_QS + (16 * ti + fr) * 272 + (32 * ks + 8 * fq) * 2);
#pragma unroll
                for (int t2 = 0; t2 < 2; ++t2) { const bf16x8 kf = *(const LAS bf16x8*)(lds + R_KS + (16 * (tj0 + t2) + fr) * 272 + (32 * ks + 8 * fq) * 2); sc[t2] = mfma16(kf, qf, sc[t2]); } }
#pragma unroll
            for (int t2 = 0; t2 < 2; ++t2) { const int i_ = 16 * ti + fr, j0 = 16 * (tj0 + t2) + 4 * fq; float pv[4];
#pragma unroll
                for (int jj = 0; jj < 4; ++jj) pv[jj] = sc[t2][jj] * exp2f(log2g * fabsf((float)(i_ - (j0 + jj))));
                u32x2 w; w.x = cvt_pk_bf16(pv[0], pv[1]); w.y = cvt_pk_bf16(pv[2], pv[3]);
                *(LAS u32x2*)(lds + R_PS + i_ * 144 + j0 * 2) = w; }
        }
        ret_state_update(lds, S, wid, fr, fq, g64);
        __syncthreads();
        const int vh = wid & 1;
        const int irow = 16 * ti + fr, grow = R0 + 64 * c + irow;
        u32x2 gg[4];
#pragma unroll
        for (int t4 = 0; t4 < 4; ++t4) gg[t4] = *(const u32x2*)(PROJ + (size_t)grow * DIN + 1536 + 128 * h + 16 * (4 * vh + t4) + 4 * fq);
        f32x4 oi[4], oc[4];
#pragma unroll
        for (int t4 = 0; t4 < 4; ++t4) { oi[t4] = (f32x4){0.f, 0.f, 0.f, 0.f}; oc[t4] = (f32x4){0.f, 0.f, 0.f, 0.f}; }
#pragma unroll
        for (int ks = 0; ks < 2; ++ks) { const bf16x8 pf = *(const LAS bf16x8*)(lds + R_PS + (16 * ti + fr) * 144 + (32 * ks + 8 * fq) * 2);
#pragma unroll
            for (int t4 = 0; t4 < 4; ++t4) { const bf16x8 vf = *(const LAS bf16x8*)(lds + R_VT + (16 * (4 * vh + t4) + fr) * 144 + (32 * ks + 8 * fq) * 2); oi[t4] = mfma16(vf, pf, oi[t4]); } }
#pragma unroll
        for (int ks = 0; ks < 4; ++ks) { const bf16x8 qf = qfr[ks];
#pragma unroll
            for (int t4 = 0; t4 < 4; ++t4) { const bf16x8 sf = *(const LAS bf16x8*)(lds + R_ST + (16 * (4 * vh + t4) + fr) * 272 + (32 * ks + 8 * fq) * 2); oc[t4] = mfma16(sf, qf, oc[t4]); } }
        const float qd = exp2f(log2g * (float)(irow + 1));
        float s1 = 0.f, s2 = 0.f;
#pragma unroll
        for (int t4 = 0; t4 < 4; ++t4) { oi[t4] = oi[t4] + oc[t4] * qd;
#pragma unroll
            for (int jj = 0; jj < 4; ++jj) { s1 += oi[t4][jj]; s2 += oi[t4][jj] * oi[t4][jj]; } }
        s1 += __shfl_xor(s1, 16); s1 += __shfl_xor(s1, 32); s2 += __shfl_xor(s2, 16); s2 += __shfl_xor(s2, 32);
        LAS f32x2* red = (LAS f32x2*)(lds + R_RED);
        if (fq == 0) red[irow * 2 + vh] = (f32x2){s1, s2};
        __syncthreads();
        const f32x2 ra = red[irow * 2], rb2 = red[irow * 2 + 1];
        const float mean = (ra[0] + rb2[0]) * (1.f / 128.f);
        const float var = (ra[1] + rb2[1]) * (1.f / 128.f) - mean * mean;
        const float rstd = rsqrtf(fmaxf(var, 0.f) + 1e-5f);
        float ss = 0.f;
#pragma unroll
        for (int t4 = 0; t4 < 4; ++t4) {
            const float g0 = bflo(gg[t4][0]), g1 = bfhi(gg[t4][0]), g2 = bflo(gg[t4][1]), g3 = bfhi(gg[t4][1]);
            const float y0 = (oi[t4][0] - mean) * rstd * siluf_(g0), y1 = (oi[t4][1] - mean) * rstd * siluf_(g1);
            const float y2 = (oi[t4][2] - mean) * rstd * siluf_(g2), y3 = (oi[t4][3] - mean) * rstd * siluf_(g3);
            ss += (y0 * y0 + y1 * y1) + (y2 * y2 + y3 * y3);
            u32x2 w; w.x = cvt_pk_bf16(y0, y1); w.y = cvt_pk_bf16(y2, y3);
            *(u32x2*)(MIXED + (size_t)grow * DM + 128 * h + 16 * (4 * vh + t4) + 4 * fq) = w;
        }
        ss += __shfl_xor(ss, 16); ss += __shfl_xor(ss, 32);
        LAS float* red2 = (LAS float*)(lds + R_RED2);
        if (fq == 0) red2[irow * 2 + vh] = ss;
        __syncthreads();
        if (tid < 64) gA[(size_t)(R0 + 64 * c + tid) * 4 + h] = red2[tid * 2] + red2[tid * 2 + 1];
    }
    if (!prompt || seg == RSEG_N - 1) { float* so = P->out + (prompt ? O_PRET + ((size_t)(L * 16 + s) * 4 + h) * 16384 : O_SRET + ((size_t)(L * 32 + (s - 16)) * 4 + h) * 16384);
#pragma unroll
      for (int tv = 0; tv < 8; ++tv)
#pragma unroll
          for (int jj = 0; jj < 4; ++jj) so[(16 * wid + 4 * fq + jj) * 128 + 16 * tv + fr] = S[tv][jj]; }
}

__device__ __forceinline__ void s5_chain(LAS unsigned char* hs  , KP P, int L, int s, int g, int lane, int sc0, int sc1, LAS f32x2* st) {
    if (sc0 >= sc1) return;
    const int fr = lane & 15, fq = lane >> 4;
    const bool prompt = s < 16;
    const int R0 = prompt ? s * 2048 : MP + (s - 16) * 64, nsub = prompt ? 128 : 4;
    const bf16_t* PROJ = (const bf16_t*)(P->ws + WS_PROJ);
    bf16_t* Yb = (bf16_t*)(P->ws + WS_Y);
    const bf16_t* Bb = (const bf16_t*)(P->ws + WS_BB) + ((size_t)(L * 16 + g) * 128) * 32;
    const bf16_t* Cp = (const bf16_t*)(P->ws + WS_CP) + ((size_t)(L * 16 + g) * 16) * 128;
    bf16x8 bfr[8], cfr[4];
#pragma unroll
    for (int nt = 0; nt < 8; ++nt) bfr[nt] = *(const bf16x8*)(Bb + (16 * nt + fr) * 32 + 8 * fq);
#pragma unroll
    for (int ks = 0; ks < 4; ++ks) cfr[ks] = *(const bf16x8*)(Cp + fr * 128 + 32 * ks + 8 * fq);
    float lre[4], lim[4], hre[4], him[4], dsk[4];
#pragma unroll
    for (int n = 0; n < 4; ++n) { const f32x2 l2 = ((const f32x2*)(P->ws + WS_LAMB))[(L * 16 + g) * 64 + 16 * n + fr]; lre[n] = l2[0]; lim[n] = l2[1]; hre[n] = 0.f; him[n] = 0.f; }
    if (!prompt) {
#pragma unroll
        for (int n = 0; n < 4; ++n) { const float* sp = P->in[3] + (((size_t)(L * 32 + (s - 16)) * 16 + g) * 64 + 16 * n + fr) * 2; hre[n] = sp[0]; him[n] = sp[1]; }
    } else if (sc0 > 0) {
#pragma unroll
        for (int n = 0; n < 4; ++n) { const f32x2 e = st[16 * n + fr]; hre[n] = e[0]; him[n] = e[1]; }
    }
#pragma unroll
    for (int jj = 0; jj < 4; ++jj) dsk[jj] = P->in[16][L * 256 + 16 * g + 4 * fq + jj];
    float pwr[4][4], pwi[4][4];
#pragma unroll
    for (int n = 0; n < 4; ++n) { pwr[n][0] = lre[n]; pwi[n][0] = lim[n];
#pragma unroll
        for (int jj = 1; jj < 4; ++jj) { pwr[n][jj] = pwr[n][jj - 1] * lre[n] - pwi[n][jj - 1] * lim[n]; pwi[n][jj] = pwr[n][jj - 1] * lim[n] + pwi[n][jj - 1] * lre[n]; } }
    const bf16_t* up0 = PROJ + (size_t)(R0 + fr) * DIN + 2048 + 16 * g;
    bf16x8 uf_n = (bf16x8){0, 0, 0, 0, 0, 0, 0, 0};
    if (fq < 2) uf_n = *(const bf16x8*)(up0 + (size_t)(16 * sc0) * DIN + 8 * fq);
    u32x2 u4_n = *(const u32x2*)(up0 + (size_t)(16 * sc0) * DIN + 4 * fq);
    for (int sc = sc0; sc < sc1; ++sc) {
        const int r0 = R0 + 16 * sc;
        const bf16x8 uf = uf_n; const u32x2 u4 = u4_n;
        if (sc + 1 < sc1) { const bf16_t* up = up0 + (size_t)(16 * (sc + 1)) * DIN; if (fq < 2) uf_n = *(const bf16x8*)(up + 8 * fq); u4_n = *(const u32x2*)(up + 4 * fq); }
        f32x4 bu[8];
#pragma unroll
        for (int nt = 0; nt < 8; ++nt) bu[nt] = mfma16(uf, bfr[nt], (f32x4){0.f, 0.f, 0.f, 0.f});
#pragma unroll
        for (int n = 0; n < 4; ++n) {
            float Lr[4], Li[4];
            Lr[0] = bu[n][0]; Li[0] = bu[n + 4][0];
#pragma unroll
            for (int jj = 1; jj < 4; ++jj) { Lr[jj] = lre[n] * Lr[jj - 1] - lim[n] * Li[jj - 1] + bu[n][jj]; Li[jj] = lre[n] * Li[jj - 1] + lim[n] * Lr[jj - 1] + bu[n + 4][jj]; }
            float Er[4], Ei[4];
#pragma unroll
            for (int k = 0; k < 4; ++k) { Er[k] = __shfl(Lr[3], 16 * k + fr); Ei[k] = __shfl(Li[3], 16 * k + fr); }
            float hr_ = hre[n], hi_ = him[n], myr = hr_, myi = hi_;
#pragma unroll
            for (int k = 0; k < 4; ++k) { const float nr = pwr[n][3] * hr_ - pwi[n][3] * hi_ + Er[k], ni = pwr[n][3] * hi_ + pwi[n][3] * hr_ + Ei[k]; hr_ = nr; hi_ = ni; if (fq == k + 1) { myr = hr_; myi = hi_; } }
            hre[n] = hr_; him[n] = hi_;
#pragma unroll
            for (int jj = 0; jj < 4; ++jj) { const float cr = Lr[jj] + (pwr[n][jj] * myr - pwi[n][jj] * myi), ci = Li[jj] + (pwr[n][jj] * myi + pwi[n][jj] * myr);
                const unsigned pk = cvt_pk_bf16(cr, ci);
                *(LAS bf16_t*)(hs + (4 * fq + jj) * 272 + (16 * n + fr) * 2) = (bf16_t)pk; *(LAS bf16_t*)(hs + (4 * fq + jj) * 272 + (64 + 16 * n + fr) * 2) = (bf16_t)(pk >> 16); }
        }
        asm volatile("s_waitcnt lgkmcnt(0)" ::: "memory");
        f32x4 y = (f32x4){0.f, 0.f, 0.f, 0.f};
#pragma unroll
        for (int ks = 0; ks < 4; ++ks) { const bf16x8 hf = *(const LAS bf16x8*)(hs + fr * 272 + (32 * ks + 8 * fq) * 2); y = mfma16(cfr[ks], hf, y); }
        asm volatile("s_waitcnt lgkmcnt(0)" ::: "memory");
        const float u0 = bflo(u4[0]), u1 = bfhi(u4[0]), u2 = bflo(u4[1]), u3 = bfhi(u4[1]);
        u32x2 w; w.x = cvt_pk_bf16(geluf_(y[0] + dsk[0] * u0), geluf_(y[1] + dsk[1] * u1)); w.y = cvt_pk_bf16(geluf_(y[2] + dsk[2] * u2), geluf_(y[3] + dsk[3] * u3));
        *(u32x2*)(Yb + (size_t)(r0 + fr) * 256 + 16 * g + 4 * fq) = w;
    }
    if (sc1 < nsub) {
        if (fq == 0) {
#pragma unroll
            for (int n = 0; n < 4; ++n) st[16 * n + fr] = (f32x2){hre[n], him[n]}; }
    } else if (fq == 0) { float* so = P->out + (prompt ? O_PSSM + ((size_t)(L * 16 + s) * 16 + g) * 128 : O_SSSM + ((size_t)(L * 32 + (s - 16)) * 16 + g) * 128);
#pragma unroll
        for (int n = 0; n < 4; ++n) { so[(16 * n + fr) * 2] = hre[n]; so[(16 * n + fr) * 2 + 1] = him[n]; } }
}

__device__ __forceinline__ void lru_m1(KP P, int L, int s, int hb, int q, int lane, int seg) {
    const int fr = lane & 15, fq = lane >> 4;
    const bool prompt = s < 16;
    const int Rs = prompt ? s * 2048 : MP + (s - 16) * 64, tb = prompt ? 256 * seg : 0, nsub = prompt ? 16 : 4;
    const bf16_t* PROJ = (const bf16_t*)(P->ws + WS_PROJ);
    unsigned* HC = (unsigned*)(P->ws + WS_HLOC);
    const int ch = 64 * hb + 16 * q + fr;
    const bf16_t* WT = (const bf16_t*)(P->ws + WS_LRUW) + ((size_t)(L * 4 + hb) * 128) * 64;
    bf16x8 wf[2][2];
#pragma unroll
    for (int tl = 0; tl < 2; ++tl)
#pragma unroll
        for (int ks = 0; ks < 2; ++ks) wf[tl][ks] = *(const bf16x8*)(WT + (64 * tl + 16 * q + fr) * 64 + 32 * ks + 8 * fq);
    const float* cwp = P->in[19] + (size_t)L * 4 * 256;
    const float* cbp = P->in[20] + L * 256;
    float cwo[4];
#pragma unroll
    for (int w = 0; w < 4; ++w) cwo[w] = cwp[w * 256 + ch];
    const float cbo = cbp[ch], ba = P->in[22][L * 256 + ch], bxb = P->in[24][L * 256 + ch];
    const float lam = P->in[25][L * 256 + ch];
    const float sp = fmaxf(-lam, 0.f) + log1pf(__expf(-fabsf(lam)));
    float hc = 0.f, ac = 1.f;
    const float* cbuf = P->in[5] + (size_t)(L * 32 + (prompt ? 0 : (s - 16))) * 3 * 256;
    u32x4 xa[2][4]; bf16_t xr[7];
    f32x4 cwa[2][4][2], cba[2][2];
#pragma unroll
    for (int ks = 0; ks < 2; ++ks) { const int ci = 64 * hb + 32 * ks + 8 * fq; cba[ks][0] = *(const f32x4*)(cbp + ci); cba[ks][1] = *(const f32x4*)(cbp + ci + 4);
#pragma unroll
        for (int w = 0; w < 4; ++w) { cwa[ks][w][0] = *(const f32x4*)(cwp + w * 256 + ci); cwa[ks][w][1] = *(const f32x4*)(cwp + w * 256 + ci + 4); } }
#define LRU_LOAD(t0_) do { \
        _Pragma("unroll") for (int ks = 0; ks < 2; ++ks) { const int ci = 64 * hb + 32 * ks + 8 * fq; \
            _Pragma("unroll") for (int w = 0; w < 4; ++w) { const int tt = (t0_) + fr + w - 3; \
                if (tt >= 0) xa[ks][w] = *(const u32x4*)(PROJ + (size_t)(Rs + tt) * DIN + 2304 + ci); \
                else if (!prompt) { const f32x4 c0 = *(const f32x4*)(cbuf + (tt + 3) * 256 + ci), c1 = *(const f32x4*)(cbuf + (tt + 3) * 256 + ci + 4); \
                    xa[ks][w] = (u32x4){cvt_pk_bf16(c0[0], c0[1]), cvt_pk_bf16(c0[2], c0[3]), cvt_pk_bf16(c1[0], c1[1]), cvt_pk_bf16(c1[2], c1[3])}; } \
                else xa[ks][w] = (u32x4){0u, 0u, 0u, 0u}; } } \
        _Pragma("unroll") for (int e = 0; e < 7; ++e) { const int tt = (t0_) + 4 * fq - 3 + e; \
            if (tt >= 0) xr[e] = PROJ[(size_t)(Rs + tt) * DIN + 2304 + ch]; \
            else if (!prompt) xr[e] = f2bf(cbuf[(tt + 3) * 256 + ch]); \
            else xr[e] = 0; } } while (0)
    LRU_LOAD(tb);
    for (int sc = 0; sc < nsub; ++sc) {
        const int t0 = tb + 16 * sc, r0 = Rs + t0;
        bf16x8 xf[2];
#pragma unroll
        for (int ks = 0; ks < 2; ++ks) {
            const int ci = 64 * hb + 32 * ks + 8 * fq;
            float xv[8];
            { const f32x4 b0 = cba[ks][0], b1 = cba[ks][1];
#pragma unroll
              for (int x = 0; x < 4; ++x) { xv[x] = b0[x]; xv[4 + x] = b1[x]; } }
#pragma unroll
            for (int w = 0; w < 4; ++w) {
                const f32x4 w0 = cwa[ks][w][0], w1 = cwa[ks][w][1];
                const u32x4 pv = xa[ks][w];
                xv[0] += w0[0] * bflo(pv[0]); xv[1] += w0[1] * bfhi(pv[0]); xv[2] += w0[2] * bflo(pv[1]); xv[3] += w0[3] * bfhi(pv[1]);
                xv[4] += w1[0] * bflo(pv[2]); xv[5] += w1[1] * bfhi(pv[2]); xv[6] += w1[2] * bflo(pv[3]); xv[7] += w1[3] * bfhi(pv[3]);
            }
            u32x4 pk; pk.x = cvt_pk_bf16(xv[0], xv[1]); pk.y = cvt_pk_bf16(xv[2], xv[3]); pk.z = cvt_pk_bf16(xv[4], xv[5]); pk.w = cvt_pk_bf16(xv[6], xv[7]);
            xf[ks] = __builtin_bit_cast(bf16x8, pk);
        }
        float xco[4];
#pragma unroll
        for (int jj = 0; jj < 4; ++jj) xco[jj] = cbo + cwo[0] * bf2f(xr[jj]) + cwo[1] * bf2f(xr[jj + 1]) + cwo[2] * bf2f(xr[jj + 2]) + cwo[3] * bf2f(xr[jj + 3]);
        if (sc + 1 < nsub) LRU_LOAD(t0 + 16);
        f32x4 pre[2];
#pragma unroll
        for (int tl = 0; tl < 2; ++tl) { pre[tl] = mfma16(xf[0], wf[tl][0], (f32x4){0.f, 0.f, 0.f, 0.f}); pre[tl] = mfma16(xf[1], wf[tl][1], pre[tl]); }
        float av[4], bv[4];
#pragma unroll
        for (int jj = 0; jj < 4; ++jj) {
            const float r = sigmoidf_(pre[0][jj] + ba), ig = sigmoidf_(pre[1][jj] + bxb);
            const float la = -8.f * r * sp;
            av[jj] = __expf(la);
            bv[jj] = sqrtf(fmaxf(1.f - av[jj] * av[jj], 0.f)) * ig * xco[jj];
        }
        float hr[4] = {0.f, 0.f, 0.f, 0.f}, ar[4] = {0.f, 0.f, 0.f, 0.f};
#pragma unroll
        for (int r = 0; r < 4; ++r) { float cur = hc, ca = ac;
#pragma unroll
            for (int jj = 0; jj < 4; ++jj) { cur = av[jj] * cur + bv[jj]; ca *= av[jj]; if (fq == r) { hr[jj] = cur; ar[jj] = ca; } }
            hc = __shfl(cur, 16 * r + fr); ac = __shfl(ca, 16 * r + fr); }
#pragma unroll
        for (int jj = 0; jj < 4; ++jj) { const size_t o = (size_t)(r0 + 4 * fq + jj) * 256 + ch; HC[o] = cvt_pk_bf16(hr[jj], ar[jj]); }
    }
#undef LRU_LOAD
    if (fq == 0) ((f32x2*)(P->ws + WS_LSUM))[(size_t)(s * 8 + seg) * 256 + ch] = (f32x2){ac, hc};
}
__device__ __forceinline__ void lru_m2(KP P, int L, int gidx, int lane) {
    const int row0 = 16 * gidx;
    const bool prompt = row0 < MP;
    const int s = prompt ? (row0 >> 11) : 16 + ((row0 - MP) >> 6), t = prompt ? (row0 & 2047) : ((row0 - MP) & 63), seg = prompt ? (t >> 8) : 0, len = prompt ? 2048 : 64;
    const bf16_t* PROJ = (const bf16_t*)(P->ws + WS_PROJ);
    bf16_t* MIXED = (bf16_t*)(P->ws + WS_MIXED);
    const unsigned* HC = (const unsigned*)(P->ws + WS_HLOC);
    float* gC = (float*)(P->ws + WS_GC);
    f32x4 hin = (f32x4){0.f, 0.f, 0.f, 0.f};
    if (!prompt) hin = *(const f32x4*)(P->in[4] + (size_t)(L * 32 + (s - 16)) * 256 + 4 * lane);
    else { const f32x2* SUMS = (const f32x2*)(P->ws + WS_LSUM) + (size_t)(s * 8) * 256 + 4 * lane;
        for (int w = 0; w < seg; ++w) {
#pragma unroll
            for (int i = 0; i < 4; ++i) { const f32x2 ab = SUMS[w * 256 + i]; hin[i] = ab[0] * hin[i] + ab[1]; } } }
    f32x4 hlast = hin;
    for (int r = 0; r < 16; ++r) {
        const int row = row0 + r;
        const u32x4 hc = *(const u32x4*)(HC + (size_t)row * 256 + 4 * lane);
        const u32x2 gt = *(const u32x2*)(PROJ + (size_t)row * DIN + 2560 + 4 * lane);
        f32x4 h; h[0] = bflo(hc[0]) + bfhi(hc[0]) * hin[0]; h[1] = bflo(hc[1]) + bfhi(hc[1]) * hin[1]; h[2] = bflo(hc[2]) + bfhi(hc[2]) * hin[2]; h[3] = bflo(hc[3]) + bfhi(hc[3]) * hin[3];
        const float o0 = h[0] * geluf_(bflo(gt[0])), o1 = h[1] * geluf_(bfhi(gt[0])), o2 = h[2] * geluf_(bflo(gt[1])), o3 = h[3] * geluf_(bfhi(gt[1]));
        u32x2 w; w.x = cvt_pk_bf16(o0, o1); w.y = cvt_pk_bf16(o2, o3);
        *(u32x2*)(MIXED + (size_t)row * DM + 768 + 4 * lane) = w;
        const float ss = wave_sum((o0 * o0 + o1 * o1) + (o2 * o2 + o3 * o3));
        if (lane == 0) gC[row] = ss;
        hlast = h;
    }
    if (t + 16 == len) {
        const int sb = prompt ? s : s - 16, NB = prompt ? 16 : 32;
        *(f32x4*)(P->out + (prompt ? O_PLRU : O_SLRU) + (size_t)(L * NB + sb) * 256 + 4 * lane) = hlast;
#pragma unroll
        for (int tau = 0; tau < 3; ++tau) { const u32x2 xv = *(const u32x2*)(PROJ + (size_t)(row0 + 13 + tau) * DIN + 2304 + 4 * lane);
            *(f32x4*)(P->out + (prompt ? O_PCONV : O_SCONV) + ((size_t)(L * NB + sb) * 3 + tau) * 256 + 4 * lane) = (f32x4){bflo(xv[0]), bfhi(xv[0]), bflo(xv[1]), bfhi(xv[1])}; }
    }
}

constexpr int S5_NS1 = MK_MULTI ? 128 : 72;
__device__ __forceinline__ void mixer1_phase(LAS unsigned char* lds, KP P, int L) {
    const int G = gridDim.x, b = blockIdx.x, NO = G - (G + 3) / 4;
    const int tid_ = opaque_tid(); const int wave = __builtin_amdgcn_readfirstlane(tid_ >> 6), lane = tid_ & 63;
    if ((b & 3) == 0) { const int chain = wave * 64 + (b >> 2); if (wave < 4 && chain < 256) s5_chain(lds + wave * 4352, P, L, chain >> 4, chain & 15, lane, 0, S5_NS1, (LAS f32x2*)(lds + 36864 + wave * 512)); return; }
    const int nb = b - (b >> 2) - 1;
    for (int id = nb; id < 448; id += NO) {
        if (id < 320) ret_pass1(lds, P, L, id / 20, (id % 20) / 5, id % 5);
        else { const int k = id - 320; ret_item(lds, P, L, 16 + (k >> 2), k & 3, 0); }
    }
    __syncthreads();
    for (int id = wave * NO + nb; id < 3072; id += 8 * NO) {
        if (id < 2048) { const int chain = id >> 3; lru_m1(P, L, chain >> 4, (chain >> 2) & 3, chain & 3, lane, id & 7); }
        else if (id < 2560) { const int k = id - 2048; s5_chain(lds + wave * 4352, P, L, 16 + (k >> 4), k & 15, lane, 0, 4, nullptr); }
        else { const int k = id - 2560; lru_m1(P, L, 16 + (k >> 4), (k >> 2) & 3, k & 3, lane, 0); }
    }
}
__device__ __forceinline__ void mixer2_phase(LAS unsigned char* lds, KP P, int L) {
    const int G = gridDim.x, b = blockIdx.x, NO = G - (G + 3) / 4;
    const int tid_ = opaque_tid(); const int wave = __builtin_amdgcn_readfirstlane(tid_ >> 6), lane = tid_ & 63;
    if ((b & 3) == 0) { const int chain = wave * 64 + (b >> 2); if (wave < 4 && chain < 256) s5_chain(lds + wave * 4352, P, L, chain >> 4, chain & 15, lane, S5_NS1, 128, (LAS f32x2*)(lds + 36864 + wave * 512)); return; }
    const int nb = b - (b >> 2) - 1;
    for (int id = nb; id < 64 * RSEG_N; id += NO) ret_item(lds, P, L, id / 24, (id % 24) / 6, id % 6);
    for (int id = wave * NO + nb; id < 2176; id += 8 * NO) lru_m2(P, L, id, lane);
}
__device__ __forceinline__ void final_phase(KP P) {
    const int tid_ = opaque_tid(); const int lane = tid_ & 63, wave = __builtin_amdgcn_readfirstlane(tid_ >> 6);
    const int gw = blockIdx.x * 8 + wave, NGW = gridDim.x * 8;
    const f32x4* sq = (const f32x4*)(P->ws + WS_SQMIX);
    f32x4 gn[4];
#pragma unroll
    for (int j = 0; j < 4; ++j) gn[j] = ((const f32x4*)P->in[30])[lane + 64 * j];
    const bf16_t* XB = (const bf16_t*)(P->ws + WS_XB);
    for (int m = gw; m < MTOT; m += NGW) {
        const float rs = rsqrtf(sum4(sq[m]) * (1.f / 1024.f) + 1e-6f);
        const u32x2* xb = (const u32x2*)(XB + (size_t)m * DM);
        f32x4* yr = (f32x4*)(P->out + (size_t)m * DM);
#pragma unroll
        for (int j = 0; j < 4; ++j) { const u32x2 w = xb[lane + 64 * j]; const f32x4 v = (f32x4){bflo(w[0]), bfhi(w[0]), bflo(w[1]), bfhi(w[1])}; yr[lane + 64 * j] = v * rs * gn[j]; }
    }
}

__device__ __forceinline__ void combine_phase(KP P) {
    const int tid_ = opaque_tid(); const int lane = tid_ & 63, wave = __builtin_amdgcn_readfirstlane(tid_ >> 6);
    const int gw = blockIdx.x * 8 + wave, NGW = gridDim.x * 8;
    const float* PART = (const float*)P->out; bf16_t* XB = (bf16_t*)(P->ws + WS_XB); float* sqn = (float*)(P->ws + WS_SQMIX);
    for (int it = gw; it < 2048 * 4; it += NGW) {
        const int r = it >> 2, pn = it & 3, row = MP + r;
        const float* p0 = PART + (size_t)((r >> 8) * 4 + pn) * 65536 + (r & 255) * 256 + 4 * lane;
        const f32x4 a = *(const f32x4*)p0 + *(const f32x4*)(p0 + (size_t)32 * 65536);
        u32x2* xp = (u32x2*)(XB + (size_t)row * DM + pn * 256 + 4 * lane);
        const u32x2 xv = *xp;
        const f32x4 xn = (f32x4){bflo(xv[0]), bfhi(xv[0]), bflo(xv[1]), bfhi(xv[1])} + a;
        u32x2 w; w.x = cvt_pk_bf16(xn[0], xn[1]); w.y = cvt_pk_bf16(xn[2], xn[3]); *xp = w;
        const float ss = wave_sum((xn[0] * xn[0] + xn[1] * xn[1]) + (xn[2] * xn[2] + xn[3] * xn[3]));
        if (lane == 0) sqn[(size_t)row * 4 + pn] = ss;
    }
}

#define XB_TMO      128
#define XB_XCNT(j)  (256  + 64 * (j))
#define XB_XSUB(j)  (1280 + 64 * (j))
#define XB_XGEN(j)  (2304 + 64 * (j))
#define XB_TOP      3328
#define XB_TOPGEN   3392
#define XCD_BAR_WORDS 3456
#define XB_SPIN_CAP (1u << 18)

__device__ __forceinline__ unsigned xb_ld(unsigned* p)              { return __hip_atomic_load(p, __ATOMIC_RELAXED, __HIP_MEMORY_SCOPE_AGENT); }
__device__ __forceinline__ unsigned xb_add(unsigned* p, unsigned v) { return __hip_atomic_fetch_add(p, v, __ATOMIC_RELAXED, __HIP_MEMORY_SCOPE_AGENT); }
__device__ __forceinline__ unsigned xb_xcc_id() { return (unsigned)__builtin_amdgcn_s_getreg((3 << 11) | 20) & 0xFu; }
#define XB_SPIN(cond, bar) do { unsigned _sp = 0; while (cond) { __builtin_amdgcn_s_sleep(1); \
    if ((++_sp & 255u) == 0u) { if (xb_ld(&(bar)[XB_TMO])) break; if (_sp > XB_SPIN_CAP) { atomicAdd(&(bar)[XB_TMO], 1u); break; } } } } while (0)

struct XcdBarrier {
    unsigned* bar; unsigned x;
    volatile LAS unsigned* st;
};

__device__ __forceinline__ XcdBarrier xcd_barrier_post(unsigned* bar, volatile LAS unsigned* st) {
    XcdBarrier b; b.bar = bar; b.x = xb_xcc_id(); b.st = st;
    if (threadIdx.x == 0) (void)xb_add(&bar[XB_XCNT(b.x)], 1u);
    return b;
}
__device__ __forceinline__ void xcd_barrier_complete(unsigned* bar, unsigned x, unsigned& nloc, unsigned& nx) {
    const unsigned G = gridDim.x * gridDim.y * gridDim.z;
    unsigned sum, cnt, mine, sp = 0u;
    for (;;) {
        sum = 0u; cnt = 0u; mine = 0u;
#pragma unroll
        for (unsigned j = 0; j < 16; ++j) { const unsigned c = xb_ld(&bar[XB_XCNT(j)]); sum += c; cnt += (c > 0u) ? 1u : 0u; mine = (j == x) ? c : mine; }
        if (sum == G) break;
        __builtin_amdgcn_s_sleep(1);
        if ((++sp & 255u) == 0u) { if (xb_ld(&bar[XB_TMO])) break; if (sp > XB_SPIN_CAP) { atomicAdd(&bar[XB_TMO], 1u); break; } }
    }
    nloc = mine > 0u ? mine : 1u; nx = cnt > 0u ? cnt : 1u;
}

__device__ __forceinline__ void xcd_barrier(const XcdBarrier& b) {
    asm volatile("s_waitcnt vmcnt(0)" ::: "memory");
    __syncthreads();
    if (threadIdx.x == 0) {
        unsigned* bar = b.bar;
        __builtin_amdgcn_s_waitcnt(0);
        unsigned nloc = b.st[0], nx = b.st[1];
        if (nloc == 0u) { xcd_barrier_complete(bar, b.x, nloc, nx); b.st[0] = nloc; b.st[1] = nx; }
        const unsigned old = xb_add(&bar[XB_XSUB(b.x)], 1u);
        const unsigned gen = old / nloc;
        if (old + 1u == (gen + 1u) * nloc) {
            __builtin_amdgcn_fence(__ATOMIC_RELEASE, "agent");
            asm volatile("s_waitcnt vmcnt(0)" ::: "memory");
            const unsigned og = xb_add(&bar[XB_TOP], 1u);
            const unsigned tg = og / nx;
            if (og + 1u == (tg + 1u) * nx) xb_add(&bar[XB_TOPGEN], 1u);
            else XB_SPIN(xb_ld(&bar[XB_TOPGEN]) == tg, bar);
            __builtin_amdgcn_fence(__ATOMIC_ACQUIRE, "agent");
            xb_add(&bar[XB_XGEN(b.x)], 1u);
            asm volatile("s_waitcnt vmcnt(0)" ::: "memory");
        } else {
            XB_SPIN(xb_ld(&bar[XB_XGEN(b.x)]) == gen, bar);
            __builtin_amdgcn_fence(__ATOMIC_ACQUIRE, "agent");
            asm volatile("s_waitcnt vmcnt(0)" ::: "memory");
        }
    }
    __syncthreads();
}


constexpr int LDS_BYTES = 131072 + 4096 + 64;
constexpr size_t WS_CTL = 0, CTL_ZERO_BYTES = 16384;
__global__ void __launch_bounds__(512, 2) mk_fwd(Params Pk) {
    extern __shared__ __attribute__((aligned(16))) unsigned char lds_raw[];
    LAS unsigned char* lds = (LAS unsigned char*)lds_raw;
    const int ph_lo = Pk.ph_lo, ph_hi = Pk.ph_hi;
    const KP pp = (KP)__builtin_amdgcn_kernarg_segment_ptr();
#if !MK_MULTI
    volatile LAS unsigned* bst = (volatile LAS unsigned*)(lds + 131072 + 4096);
    if (threadIdx.x < 2) bst[threadIdx.x] = 0u;
    __syncthreads();
    const XcdBarrier gbar = xcd_barrier_post((unsigned*)(Pk.ws + WS_CTL), bst);
#endif
    for (int ph = ph_lo; ph < ph_hi; ++ph) {
        KP P = pp; asm volatile("" : "+s"(P));
        unsigned char* ws = P->ws; const int G = gridDim.x;
        LAS float* part = (LAS float*)(lds + 131072);
        bf16_t* XB = (bf16_t*)(ws + WS_XB); bf16_t* MIXED = (bf16_t*)(ws + WS_MIXED); bf16_t* Yb = (bf16_t*)(ws + WS_Y); bf16_t* PROJ = (bf16_t*)(ws + WS_PROJ);
        for (int rep_ = 0; rep_ < ((ph > 0 && ph < NPH - 1 && (ph - 1) % NSUB == REP_SUB) ? 2 : 1); ++rep_) {
        if (ph == 0) { prologue(lds, P);
#if PROBE_PRO
            __syncthreads(); prologue(lds, P);
#endif
        }
        else if (ph == NPH - 1) final_phase(P);
        else {
            const int L = (ph - 1) / NSUB, sub = (ph - 1) % NSUB;
            unsigned char* wl = ws + WS_W + (size_t)L * WL_STRIDE;
            pg8::StaticOrder S;
            if (sub == 0) {
                pg8::Gemm g{XB, (const bf16_t*)(wl + WL_IN), MTOT, DIN, DM}; S.init(MTOT, DIN, G, (int)blockIdx.x);
                EpiProj E{PROJ, (const f32x4*)(ws + WS_SQMIX), (const f32x4*)(ws + WS_ROT)};
                pg8::gemm_phase<EpiProj>(lds, g, S, E);
            } else if (sub == 1) {
                mixer1_phase(lds, P, L);
            } else if (sub == 2) {
                mixer2_phase(lds, P, L);
#if PROBE_M12 && !MK_MULTI
                xcd_barrier(gbar); mixer1_phase(lds, P, L); xcd_barrier(gbar); mixer2_phase(lds, P, L);
#endif
            } else if (sub == 3) {
                pg8::Gemm g{Yb, (const bf16_t*)(wl + WL_GLU), MTOT, 512, 256}; S.init(MTOT, 512, G, (int)blockIdx.x);
                EpiGLU E{MIXED, (float*)(ws + WS_GB), part};
                pg8::gemm_phase<EpiGLU>(lds, g, S, E);
            } else if (sub == 4) {
                pg8::Gemm g{MIXED, (const bf16_t*)(wl + WL_OUT), MTOT, DM, DM}; S.init(MTOT, DM, G, (int)blockIdx.x);
                EpiRes<true> E{nullptr, XB, (float*)(ws + WS_SQFFN), (const f32x4*)(ws + WS_GA), (const f32x2*)(ws + WS_GB), (const float*)(ws + WS_GC), part};
                pg8::gemm_phase<EpiRes<true>>(lds, g, S, E);
            } else if (sub == 5) {
                pg8::Gemm g{XB, (const bf16_t*)(wl + WL_GU), MTOT, 2 * DFF, DM}; S.init(MTOT, 2 * DFF, G, (int)blockIdx.x);
                EpiSwiGLU E{PROJ  , (const f32x4*)(ws + WS_SQFFN)};
                pg8::gemm_phase<EpiSwiGLU>(lds, g, S, E);
            } else {
#if MK_MULTI
                pg8::Gemm g{PROJ, (const bf16_t*)(wl + WL_DN), MTOT, DM, DFF}; S.init(MTOT, DM, G, (int)blockIdx.x);
                EpiRes<false> E{nullptr, XB, (float*)(ws + WS_SQMIX), nullptr, nullptr, nullptr, part};
                pg8::gemm_phase<EpiRes<false>>(lds, g, S, E);
#else
                { pg8::Gemm g{PROJ, (const bf16_t*)(wl + WL_DN), MP, DM, DFF}; S.init(MP, DM, G, (int)blockIdx.x);
                  EpiRes<false> E{nullptr, XB, (float*)(ws + WS_SQMIX), nullptr, nullptr, nullptr, part};
                  pg8::gemm_phase<EpiRes<false>>(lds, g, S, E); }
                { pg8::Gemm g{PROJ + (size_t)MP * DFF, (const bf16_t*)(wl + WL_DN), 2048, 2048, DFF / 2, DFF}; S.init(2048, 2048, G, (int)blockIdx.x);
                  EpiPart E{P->out};
                  pg8::gemm_phase<EpiPart>(lds, g, S, E); }
                if (L + 1 < DEPTH && (int)blockIdx.x >= 64 && G > 64) {
                    const int tid_ = opaque_tid(); const int wave = __builtin_amdgcn_readfirstlane(tid_ >> 6), lane = tid_ & 63;
                    convert_layer_weights(lds, P, L + 1, ((int)blockIdx.x - 64) * 8 + wave, (G - 64) * 8, wave, lane);
                }
                xcd_barrier(gbar);
                combine_phase(P);
#endif
            }
        }
        }
#if !MK_MULTI
        if (ph + 1 < ph_hi) {
            if (ph == ph_lo) {
                asm volatile("s_waitcnt vmcnt(0)" ::: "memory"); __syncthreads();
                if (threadIdx.x == 0) { __builtin_amdgcn_fence(__ATOMIC_RELEASE, "agent"); asm volatile("s_waitcnt vmcnt(0)" ::: "memory"); }
                __syncthreads();
                cg::this_grid().sync();
                if (threadIdx.x == 0) { __builtin_amdgcn_fence(__ATOMIC_ACQUIRE, "agent"); asm volatile("s_waitcnt vmcnt(0)" ::: "memory"); }
                __syncthreads();
            } else xcd_barrier(gbar);
        }
#endif
    }
}

extern "C" void kernel_launch(void* const* d_in, const int* in_sizes, int n_in, void* d_out, int out_size, void* d_ws, size_t ws_size, hipStream_t stream) {
    static int grid = 0;
    if (grid == 0) {
        if (n_in != 31 || ws_size < WS_END) { fprintf(stderr, "kernel_launch: expected 31 inputs and >= %zu B of workspace (got %d, %zu)\n", (size_t)WS_END, n_in, ws_size); grid = -1; return; }
        if (hipFuncSetAttribute((const void*)mk_fwd, hipFuncAttributeMaxDynamicSharedMemorySize, LDS_BYTES) != hipSuccess) { fprintf(stderr, "kernel_launch: hipFuncSetAttribute failed\n"); grid = -1; return; }
        int dev = 0, cus = 0, per_cu = 0;
        hipGetDevice(&dev); hipDeviceGetAttribute(&cus, hipDeviceAttributeMultiprocessorCount, dev);
        hipOccupancyMaxActiveBlocksPerMultiprocessor(&per_cu, (const void*)mk_fwd, 512, LDS_BYTES);
        (void)hipGetLastError();
        grid = cus * (per_cu < 1 ? 1 : per_cu);
        if (grid > 256) grid = 256;
        if (grid < 128) { fprintf(stderr, "kernel_launch: grid %d too small for the mixer phase layout\n", grid); grid = -1; return; }
    }
    if (grid < 0) return;
#if !MK_MULTI
    if (hipMemsetAsync((char*)d_ws + WS_CTL, 0, CTL_ZERO_BYTES, stream) != hipSuccess) { fprintf(stderr, "kernel_launch: memset of the barrier words failed\n"); return; }
#endif
    Params p{};
    for (int i = 0; i < 31; ++i) p.in[i] = (const float*)d_in[i];
    p.out = (float*)d_out; p.ws = (unsigned char*)d_ws;
#if MK_MULTI
    for (int ph = 0; ph < NPH; ++ph) { p.ph_lo = ph; p.ph_hi = ph + 1; hipLaunchKernelGGL(mk_fwd, dim3(grid), dim3(512), LDS_BYTES, stream, p); }
#else
    p.ph_lo = 0; p.ph_hi = NPH;
    void* args[] = {&p};
    hipError_t e = hipLaunchCooperativeKernel((const void*)mk_fwd, dim3(grid), dim3(512), args, LDS_BYTES, stream);
    if (e != hipSuccess) fprintf(stderr, "kernel_launch: cooperative launch failed: %s (grid %d)\n", hipGetErrorString(e), grid);
#endif
}
```

```cpp
#include <hip/hip_runtime.h>
#include <hip/hip_cooperative_groups.h>
#include <cstdio>
#include <cstdint>
namespace cg = cooperative_groups;

#ifndef MK_MULTI
#define MK_MULTI 0
#endif

#ifndef PROBE_PRO
#define PROBE_PRO 0
#endif
#ifndef PROBE_M12
#define PROBE_M12 0
#endif
#ifndef REP_SUB
#define REP_SUB -1
#endif
#define LAS __attribute__((address_space(3)))
typedef unsigned short bf16_t;
typedef short bf16x8 __attribute__((ext_vector_type(8)));
typedef float f32x4 __attribute__((ext_vector_type(4)));
typedef float f32x2 __attribute__((ext_vector_type(2)));
typedef unsigned u32x4 __attribute__((ext_vector_type(4)));
typedef unsigned u32x2 __attribute__((ext_vector_type(2)));

constexpr int DM = 1024, MP = 32768, MTOT = 34816, DIN = 2816, DFF = 2816, DEPTH = 4;
constexpr int NSUB = 7, NPH = 2 + NSUB * DEPTH;
constexpr size_t O_PRET = 35651584, O_PSSM = 39845888, O_PLRU = 39976960, O_PCONV = 39993344;
constexpr size_t O_SRET = 40042496, O_SSSM = 48431104, O_SLRU = 48693248, O_SCONV = 48726016;
constexpr size_t MiB = 1u << 20;
constexpr size_t WS_ROT = 3 * MiB;
constexpr size_t WS_LAMB = 4 * MiB;
constexpr size_t WS_BB = 4 * MiB + 64 * 1024;
constexpr size_t WS_CP = 4 * MiB + 640 * 1024;
constexpr size_t WS_LRUW = 4 * MiB + 896 * 1024;
constexpr size_t WS_W = 6 * MiB;
constexpr size_t WL_IN = 0, WL_OUT = 5767168, WL_GU = WL_OUT + 2097152, WL_DN = WL_GU + 11534336, WL_GLU = WL_DN + 5767168, WL_STRIDE = WL_GLU + 262144;
constexpr size_t WS_XB = 104 * MiB, WS_MIXED = 172 * MiB, WS_Y = 240 * MiB, WS_PROJ = 258 * MiB;
constexpr size_t WS_SQMIX = 445 * MiB, WS_SQFFN = 446 * MiB, WS_GA = 447 * MiB, WS_GB = 448 * MiB, WS_GC = 449 * MiB;
constexpr size_t OUT_U = 0, OUT_CUMA = 32 * MiB  , WS_HLOC = 452 * MiB, WS_S5E = 488 * MiB  , WS_LSUM = 487 * MiB, WS_END = 492 * MiB;
static_assert(WS_W + 4 * WL_STRIDE <= WS_XB, "ws map");
__device__ __forceinline__ float sum4(const f32x4 v) { return (v[0] + v[1]) + (v[2] + v[3]); }

struct Params { const float* in[31]; float* out; unsigned char* ws; int ph_lo, ph_hi; };
typedef const __attribute__((address_space(4))) Params* KP;

__device__ __forceinline__ int opaque_tid() { int t = threadIdx.x; asm volatile("" : "+v"(t)); return t; }
__device__ __forceinline__ unsigned cvt_pk_bf16(float lo, float hi) { unsigned r; asm volatile("v_cvt_pk_bf16_f32 %0, %1, %2" : "=v"(r) : "v"(lo), "v"(hi)); return r; }
__device__ __forceinline__ bf16_t f2bf(float f) { return (bf16_t)(cvt_pk_bf16(f, 0.f) & 0xffffu); }
__device__ __forceinline__ float bf2f(bf16_t h) { return __builtin_bit_cast(float, (unsigned)h << 16); }
__device__ __forceinline__ float bflo(unsigned w) { return __builtin_bit_cast(float, w << 16); }
__device__ __forceinline__ float bfhi(unsigned w) { return __builtin_bit_cast(float, w & 0xffff0000u); }
__device__ __forceinline__ float sigmoidf_(float x) { return __builtin_amdgcn_rcpf(1.f + __expf(-x)); }
__device__ __forceinline__ float siluf_(float x) { return x * sigmoidf_(x); }
__device__ __forceinline__ float geluf_(float x) { return x * sigmoidf_(1.5957691216f * (x + 0.044715f * x * x * x)); }
__device__ __forceinline__ f32x4 mfma16(bf16x8 a, bf16x8 b, f32x4 c) { return __builtin_amdgcn_mfma_f32_16x16x32_bf16(a, b, c, 0, 0, 0); }

namespace pg8 {
constexpr int BM = 256, BK = 64, HALF = 128, HTB = HALF * BK * 2, STAGE_BYTES = 8 * HTB, NXCD = 8, WGM = 4;
__host__ __device__ __forceinline__ int lds_byte(int r, int c) { const int st = (r >> 4) * 2 + (c >> 5), rr = r & 15, cc = c & 31, ob = rr * 64 + cc * 2; return st * 1024 + (ob ^ (((ob >> 9) & 1) << 5)); }
__host__ __device__ __forceinline__ void stage_rc(int b, int& R, int& C) { const int st = b / 1024, sb = b % 1024, swz = sb ^ (((sb >> 9) & 1) << 5); R = (st >> 1) * 16 + swz / 64; C = (st & 1) * 32 + (swz % 64) / 2; }
__host__ __device__ __forceinline__ int perm32(int rho) { const int n = rho >> 4, i = rho & 15; return 8 * (i >> 2) + 4 * n + (i & 3); }
struct Unit { int pm, pn; };
struct Gemm { const bf16_t* A; const bf16_t* Bt; int M, N, K; int ld = 0; };
struct StaticOrder {
    int nM, nN, nwg, G, c;
    __device__ void init(int M, int N, int G_, int c_) { nM = M / BM; nN = N / BM; nwg = nM * nN; G = G_; c = c_; }
    __device__ bool next(int i, Unit& u) const {
        const long L = (long)i * G + c; if (L >= nwg) return false;
        int wgid = (int)L; { const int q = nwg / NXCD, r = nwg % NXCD, xcd = wgid % NXCD, off = wgid / NXCD; wgid = (xcd < r ? xcd * (q + 1) : r * (q + 1) + (xcd - r) * q) + off; }
        const int nig = WGM * nN, gid = wgid / nig, fm = gid * WGM, gsz = (nM - fm) < WGM ? (nM - fm) : WGM;
        u.pm = fm + ((wgid % nig) % gsz); u.pn = (wgid % nig) / gsz; return true;
    }
};
template <class Epi>
__device__ __forceinline__ void gemm_phase(LAS unsigned char* lds, const Gemm g, const StaticOrder& S, const Epi& E) {
    const int tid = opaque_tid(), wid = __builtin_amdgcn_readfirstlane(tid >> 6), lane = tid & 63, wr = wid >> 2, wc = wid & 3, fr = lane & 15, fq = lane >> 4;
    const int K = g.ld ? g.ld : g.K, nt = g.K / BK;
    unsigned voffA[2], voffB[2];
#pragma unroll
    for (int i = 0; i < 2; ++i) { int R, C; stage_rc(tid * 16 + i * 8192, R, C); const int Rb = Epi::PERM ? ((R & ~31) + perm32(R & 31)) : R;
        voffA[i] = (unsigned)(R * K + C) * 2u; voffB[i] = (unsigned)(Rb * K + C) * 2u; }
    const size_t kstep = (size_t)(BK * 2);
    const size_t hstep = (size_t)HALF * K * 2;
    const size_t tstep = 2 * hstep;
    const unsigned ldsw = (unsigned)wid * 1024u;
    const int aoff = lds_byte(wr * 64 + fr, fq * 8), boff = lds_byte(wc * 32 + fr, fq * 8);
#define PG8_SA(b, h) (((b) * 2 + (h)) * HTB)
#define PG8_SB(b, h) ((4 + (b) * 2 + (h)) * HTB)
#define PG8_STAGE(bufoff, gbase, voff) do { _Pragma("unroll") for (int _i = 0; _i < 2; ++_i) \
        __builtin_amdgcn_global_load_lds((const unsigned*)((const char*)(gbase) + (voff)[_i]), (LAS unsigned*)(lds + (bufoff) + ldsw + _i * 8192), 16, 0, 0); } while (0)
#define PG8_LDA(dst, b, h) do { _Pragma("unroll") for (int m = 0; m < 4; ++m) _Pragma("unroll") for (int k = 0; k < 2; ++k) dst[m][k] = *(const LAS bf16x8*)(lds + PG8_SA(b, h) + aoff + m * 2048 + k * 1024); } while (0)
#define PG8_LDB(dst, b, h) do { _Pragma("unroll") for (int n = 0; n < 2; ++n) _Pragma("unroll") for (int k = 0; k < 2; ++k) dst[n][k] = *(const LAS bf16x8*)(lds + PG8_SB(b, h) + boff + n * 2048 + k * 1024); } while (0)
#define PG8_MMA(ai, bj, At, Bt) do { __builtin_amdgcn_s_setprio(1); _Pragma("unroll") for (int m = 0; m < 4; ++m) _Pragma("unroll") for (int n = 0; n < 2; ++n) _Pragma("unroll") for (int k = 0; k < 2; ++k) \
        acc[ai][bj][m][n] = __builtin_amdgcn_mfma_f32_16x16x32_bf16(Bt[n][k], At[m][k], acc[ai][bj][m][n], 0, 0, 0); __builtin_amdgcn_s_setprio(0); } while (0)
#define PG8_WAIT_V(n) asm volatile("s_waitcnt vmcnt(" #n ")" ::: "memory")
#define PG8_WAIT_L(n) asm volatile("s_waitcnt lgkmcnt(" #n ")" ::: "memory")
#define PG8_BAR __builtin_amdgcn_s_barrier()
#define PG8_SCHED __builtin_amdgcn_sched_barrier(0)
    Unit cur, nxt; int ui = 0;
    if (!S.next(0, cur)) return;
    f32x4 acc[2][2][4][2];
#pragma unroll
    for (int a = 0; a < 2; ++a)
#pragma unroll
        for (int b = 0; b < 2; ++b)
#pragma unroll
            for (int m = 0; m < 4; ++m)
#pragma unroll
                for (int n = 0; n < 2; ++n) acc[a][b][m][n] = (f32x4){0.f, 0.f, 0.f, 0.f};
    bf16x8 At[4][2], B0[2][2], B1[2][2];
    const size_t kh = (size_t)g.K * 2;
    const char* cA = (const char*)g.A + (size_t)cur.pm * tstep + (Epi::SPLITK ? (size_t)(cur.pn >> 2) * kh : 0); const char* cB = (const char*)g.Bt + (size_t)(Epi::SPLITK ? (cur.pn & 3) : cur.pn) * tstep + (Epi::SPLITK ? (size_t)(cur.pn >> 2) * kh : 0);
    PG8_STAGE(PG8_SB(0, 0), cB, voffB); PG8_STAGE(PG8_SB(0, 1), cB + hstep, voffB); PG8_STAGE(PG8_SA(0, 0), cA, voffA); PG8_STAGE(PG8_SA(0, 1), cA + hstep, voffA);
    if (wr == 1) PG8_BAR;
    PG8_WAIT_V(2); PG8_BAR;
    PG8_STAGE(PG8_SB(1, 0), cB + kstep, voffB); PG8_STAGE(PG8_SA(1, 0), cA + kstep, voffA); PG8_STAGE(PG8_SB(1, 1), cB + hstep + kstep, voffB);
    PG8_WAIT_V(6); PG8_BAR;
    for (;;) {
        const bool has_next = S.next(ui + 1, nxt);
        const char* nA = has_next ? (const char*)g.A + (size_t)nxt.pm * tstep + (Epi::SPLITK ? (size_t)(nxt.pn >> 2) * kh : 0) : cA; const char* nB = has_next ? (const char*)g.Bt + (size_t)(Epi::SPLITK ? (nxt.pn & 3) : nxt.pn) * tstep + (Epi::SPLITK ? (size_t)(nxt.pn >> 2) * kh : 0) : cB;
#pragma unroll 1
        for (int t = 0; t < nt; t += 2) {
            const bool last = (t == nt - 2);
            const char* a1 = cA + (size_t)(t + 1) * kstep;
            const char* a2 = last ? nA : cA + (size_t)(t + 2) * kstep; const char* b2 = last ? nB : cB + (size_t)(t + 2) * kstep;
            const char* a3 = a2 + kstep; const char* b3 = b2 + kstep;
            if constexpr (Epi::HOOK) { E.khook(acc, t, cur, wr, fr); PG8_SCHED; }
            PG8_LDB(B0, 0, 0); PG8_LDB(B1, 0, 1); PG8_SCHED; PG8_LDA(At, 0, 0); PG8_STAGE(PG8_SA(1, 1), a1 + hstep, voffA);
            PG8_WAIT_V(8); PG8_WAIT_L(0); PG8_BAR; PG8_MMA(0, 0, At, B0); PG8_MMA(0, 1, At, B1); PG8_BAR; PG8_SCHED;
            PG8_LDA(At, 0, 1); PG8_STAGE(PG8_SB(0, 0), b2, voffB); PG8_STAGE(PG8_SB(0, 1), b2 + hstep, voffB); PG8_STAGE(PG8_SA(0, 0), a2, voffA);
            PG8_WAIT_V(8); PG8_WAIT_L(0); PG8_BAR; PG8_MMA(1, 0, At, B0); PG8_MMA(1, 1, At, B1); PG8_BAR; PG8_SCHED;
            PG8_LDB(B0, 1, 0); PG8_LDB(B1, 1, 1); PG8_SCHED; PG8_LDA(At, 1, 0); PG8_STAGE(PG8_SA(0, 1), a2 + hstep, voffA);
            PG8_WAIT_V(8); PG8_WAIT_L(0); PG8_BAR; PG8_MMA(0, 0, At, B0); PG8_MMA(0, 1, At, B1); PG8_BAR; PG8_SCHED;
            PG8_LDA(At, 1, 1); PG8_STAGE(PG8_SB(1, 0), b3, voffB); PG8_STAGE(PG8_SB(1, 1), b3 + hstep, voffB); PG8_STAGE(PG8_SA(1, 0), a3, voffA);
            PG8_WAIT_V(8); PG8_WAIT_L(0); PG8_BAR; PG8_MMA(1, 0, At, B0); PG8_MMA(1, 1, At, B1); PG8_BAR; PG8_SCHED;
        }
        if (wr == 0) PG8_BAR;
        E(acc, cur, wr, wc, fr, fq);
        if (!has_next) break;
#pragma unroll
        for (int a = 0; a < 2; ++a)
#pragma unroll
            for (int b = 0; b < 2; ++b)
#pragma unroll
                for (int m = 0; m < 4; ++m)
#pragma unroll
                    for (int n = 0; n < 2; ++n) acc[a][b][m][n] = (f32x4){0.f, 0.f, 0.f, 0.f};
        cur = nxt; cA = nA; cB = nB; ++ui;
        if (wr == 1) PG8_BAR;
    }
    PG8_WAIT_V(0);
    PG8_BAR;
#undef PG8_SA
#undef PG8_SB
#undef PG8_STAGE
#undef PG8_LDA
#undef PG8_LDB
#undef PG8_MMA
#undef PG8_WAIT_V
#undef PG8_WAIT_L
#undef PG8_BAR
#undef PG8_SCHED
}
}
using pg8::Unit;
typedef f32x4 Acc[2][2][4][2];

struct EpiProj {
    static constexpr bool PERM = true, HOOK = false, SPLITK = false;
    bf16_t* O; const f32x4* sq; const f32x4* rot;
    __device__ __forceinline__ void operator()(const Acc& acc, const Unit& u, int wr, int wc, int fr, int fq) const {
        const int row0 = u.pm * 256 + wr * 64 + fr, pn = u.pn;
        if (pn < 4) {
            const float qs = (pn < 2) ? 0.08838834764831845f : 1.f;
            const int idx0 = 32 * (wc & 1) + 8 * fq;
            const int lcol = 256 * pn + 128 * (wc >> 1) + idx0;
#pragma unroll
            for (int ai = 0; ai < 2; ++ai)
#pragma unroll
                for (int m = 0; m < 4; ++m) {
                    const int row = row0 + ai * 128 + m * 16;
                    const float rs = rsqrtf(sum4(sq[row]) * (1.f / 1024.f) + 1e-6f) * qs;
                    const int pos = row < MP ? (row & 2047) : 1024 + ((row - MP) & 63);
                    const f32x4* rp = rot + pos * 32 + (idx0 >> 1);
                    const f32x4 c0 = rp[0], c1 = rp[1], c2 = rp[2], c3 = rp[3];
                    const f32x4 a0 = acc[ai][0][m][0] * rs, a1 = acc[ai][0][m][1] * rs, b0 = acc[ai][1][m][0] * rs, b1 = acc[ai][1][m][1] * rs;
                    u32x4 w1, w2;
                    w1.x = cvt_pk_bf16(a0[0] * c0[0] - b0[0] * c0[1], a0[1] * c0[2] - b0[1] * c0[3]);
                    w1.y = cvt_pk_bf16(a0[2] * c1[0] - b0[2] * c1[1], a0[3] * c1[2] - b0[3] * c1[3]);
                    w1.z = cvt_pk_bf16(a1[0] * c2[0] - b1[0] * c2[1], a1[1] * c2[2] - b1[1] * c2[3]);
                    w1.w = cvt_pk_bf16(a1[2] * c3[0] - b1[2] * c3[1], a1[3] * c3[2] - b1[3] * c3[3]);
                    w2.x = cvt_pk_bf16(b0[0] * c0[0] + a0[0] * c0[1], b0[1] * c0[2] + a0[1] * c0[3]);
                    w2.y = cvt_pk_bf16(b0[2] * c1[0] + a0[2] * c1[1], b0[3] * c1[2] + a0[3] * c1[3]);
                    w2.z = cvt_pk_bf16(b1[0] * c2[0] + a1[0] * c2[1], b1[1] * c2[2] + a1[1] * c2[3]);
                    w2.w = cvt_pk_bf16(b1[2] * c3[0] + a1[2] * c3[1], b1[3] * c3[2] + a1[3] * c3[3]);
                    bf16_t* op = O + (size_t)row * DIN + lcol;
                    *(u32x4*)op = w1; *(u32x4*)(op + 64) = w2;
                }
        } else {
            const int col0 = 256 * pn + 32 * wc + 8 * fq;
#pragma unroll
            for (int ai = 0; ai < 2; ++ai)
#pragma unroll
                for (int m = 0; m < 4; ++m) {
                    const int row = row0 + ai * 128 + m * 16;
                    const float rs = rsqrtf(sum4(sq[row]) * (1.f / 1024.f) + 1e-6f);
                    bf16_t* op = O + (size_t)row * DIN + col0;
#pragma unroll
                    for (int bj = 0; bj < 2; ++bj) { const f32x4 v0 = acc[ai][bj][m][0] * rs, v1 = acc[ai][bj][m][1] * rs; u32x4 w;
                        w.x = cvt_pk_bf16(v0[0], v0[1]); w.y = cvt_pk_bf16(v0[2], v0[3]); w.z = cvt_pk_bf16(v1[0], v1[1]); w.w = cvt_pk_bf16(v1[2], v1[3]);
                        *(u32x4*)(op + bj * 128) = w; }
                }
        }
    }
};
template <bool GRP> struct EpiRes {
    static constexpr bool PERM = false, HOOK = GRP, SPLITK = false;
    float* X  ; bf16_t* XB  ; float* sqn; const f32x4* gA; const f32x2* gB; const float* gC; LAS float* part;
    __device__ __forceinline__ float gcsum(unsigned row) const { return gC[row]; }
    __device__ __forceinline__ void khook(Acc& acc, int t, const Unit& u, int wr, int fr) const {
        if (t == 8 || t == 12) {
            asm volatile("" : "+v"(fr));
#pragma unroll
            for (int ai = 0; ai < 2; ++ai)
#pragma unroll
                for (int m = 0; m < 4; ++m) {
                    const unsigned row = (unsigned)(u.pm * 256 + ai * 128 + wr * 64 + m * 16 + fr);
                    const f32x2 gb = gB[row]; const float sB = (gb[0] + gb[1]) * (1.f / 256.f) + 1e-6f;
                    float ratio;
                    if (t == 8) ratio = sqrtf(sB / (sum4(gA[row]) * (1.f / 512.f) + 1e-6f));
                    else ratio = sqrtf((gcsum(row) * (1.f / 256.f) + 1e-6f) / sB);
                    asm volatile("" ::: "memory");
#pragma unroll
                    for (int bj = 0; bj < 2; ++bj)
#pragma unroll
                        for (int n = 0; n < 2; ++n) acc[ai][bj][m][n] *= ratio;
                }
        }
    }
    __device__ __forceinline__ void operator()(const Acc& acc, const Unit& u, int wr, int wc, int fr, int fq) const {
        const int row0 = u.pm * 256 + wr * 64 + fr, col0 = u.pn * 256 + wc * 32 + 4 * fq;
#pragma unroll
        for (int ai = 0; ai < 2; ++ai)
#pragma unroll
            for (int m = 0; m < 4; ++m) {
                const int row = row0 + ai * 128 + m * 16;
                float sc = 1.f; if (GRP) sc = rsqrtf(gcsum((unsigned)row) * (1.f / 256.f) + 1e-6f);
                const unsigned off = (unsigned)row * DM + col0; float ss = 0.f;
#pragma unroll
                for (int bj = 0; bj < 2; ++bj)
#pragma unroll
                    for (int n = 0; n < 2; ++n) {
                        const u32x2 xr = *(const u32x2*)(XB + off + bj * 128 + n * 16);
                        const f32x4 xo = (f32x4){bflo(xr[0]), bfhi(xr[0]), bflo(xr[1]), bfhi(xr[1])};
                        const f32x4 xn = xo + acc[ai][bj][m][n] * sc;
                        if (X) *(f32x4*)(X + off + bj * 128 + n * 16) = xn;
                        u32x2 w; w.x = cvt_pk_bf16(xn[0], xn[1]); w.y = cvt_pk_bf16(xn[2], xn[3]);
                        *(u32x2*)(XB + off + bj * 128 + n * 16) = w;
                        ss += (xn[0] * xn[0] + xn[1] * xn[1]) + (xn[2] * xn[2] + xn[3] * xn[3]);
                    }
                ss += __shfl_xor(ss, 16); ss += __shfl_xor(ss, 32);
                if (fq == 0) part[wc * 256 + ai * 128 + wr * 64 + m * 16 + fr] = ss;
                asm volatile("" ::: "memory");
            }
        asm volatile("s_waitcnt lgkmcnt(0)" ::: "memory"); __builtin_amdgcn_s_barrier(); asm volatile("" ::: "memory");
        { const int t_ = (wr * 4 + wc) * 64 + fq * 16 + fr;
          if (t_ < 256) sqn[(size_t)(u.pm * 256 + t_) * 4 + u.pn] = (part[t_] + part[256 + t_]) + (part[512 + t_] + part[768 + t_]); }
        asm volatile("s_waitcnt lgkmcnt(0)" ::: "memory"); __builtin_amdgcn_s_barrier(); asm volatile("" ::: "memory");
    }
};
struct EpiPart {
    static constexpr bool PERM = false, HOOK = false, SPLITK = true;
    float* PART;
    __device__ __forceinline__ void operator()(const Acc& acc, const Unit& u, int wr, int wc, int fr, int fq) const {
        float* base = PART + (size_t)((u.pn >> 2) * 32 + u.pm * 4 + (u.pn & 3)) * 65536 + (wr * 64 + fr) * 256 + wc * 32 + 4 * fq;
#pragma unroll
        for (int ai = 0; ai < 2; ++ai)
#pragma unroll
            for (int m = 0; m < 4; ++m)
#pragma unroll
                for (int bj = 0; bj < 2; ++bj)
#pragma unroll
                    for (int n = 0; n < 2; ++n) *(f32x4*)(base + (ai * 128 + m * 16) * 256 + bj * 128 + n * 16) = acc[ai][bj][m][n];
    }
};
struct EpiSwiGLU {
    static constexpr bool PERM = true, HOOK = false, SPLITK = false;
    bf16_t* O; const f32x4* sq;
    __device__ __forceinline__ void operator()(const Acc& acc, const Unit& u, int wr, int wc, int fr, int fq) const {
        const int row0 = u.pm * 256 + wr * 64 + fr, col0 = 128 * u.pn + 32 * wc + 8 * fq;
#pragma unroll
        for (int ai = 0; ai < 2; ++ai)
#pragma unroll
            for (int m = 0; m < 4; ++m) {
                const int row = row0 + ai * 128 + m * 16;
                const float rs = rsqrtf(sum4(sq[row]) * (1.f / 1024.f) + 1e-6f);
                float o[8];
#pragma unroll
                for (int n = 0; n < 2; ++n)
#pragma unroll
                    for (int i = 0; i < 4; ++i) { const float gt = acc[ai][0][m][n][i] * rs, up = acc[ai][1][m][n][i] * rs; o[4 * n + i] = siluf_(gt) * up; }
                u32x4 w; w.x = cvt_pk_bf16(o[0], o[1]); w.y = cvt_pk_bf16(o[2], o[3]); w.z = cvt_pk_bf16(o[4], o[5]); w.w = cvt_pk_bf16(o[6], o[7]);
                *(u32x4*)(O + (size_t)row * DFF + col0) = w;
            }
    }
};
struct EpiGLU {
    static constexpr bool PERM = true, HOOK = false, SPLITK = false;
    bf16_t* O; float* gB; LAS float* part;
    __device__ __forceinline__ void operator()(const Acc& acc, const Unit& u, int wr, int wc, int fr, int fq) const {
        const int row0 = u.pm * 256 + wr * 64 + fr, col0 = 512 + 128 * u.pn + 32 * wc + 8 * fq;
#pragma unroll
        for (int ai = 0; ai < 2; ++ai)
#pragma unroll
            for (int m = 0; m < 4; ++m) {
                const int row = row0 + ai * 128 + m * 16;
                float o[8]; float ss = 0.f;
#pragma unroll
                for (int n = 0; n < 2; ++n)
#pragma unroll
                    for (int i = 0; i < 4; ++i) { const float v = acc[ai][0][m][n][i] * sigmoidf_(acc[ai][1][m][n][i]); o[4 * n + i] = v; ss += v * v; }
                u32x4 w; w.x = cvt_pk_bf16(o[0], o[1]); w.y = cvt_pk_bf16(o[2], o[3]); w.z = cvt_pk_bf16(o[4], o[5]); w.w = cvt_pk_bf16(o[6], o[7]);
                *(u32x4*)(O + (size_t)row * DM + col0) = w;
                ss += __shfl_xor(ss, 16); ss += __shfl_xor(ss, 32);
                if (fq == 0) part[wc * 256 + ai * 128 + wr * 64 + m * 16 + fr] = ss;
            }
        asm volatile("s_waitcnt lgkmcnt(0)" ::: "memory"); __builtin_amdgcn_s_barrier(); asm volatile("" ::: "memory");
        { const int t_ = (wr * 4 + wc) * 64 + fq * 16 + fr;
          if (t_ < 256) gB[(size_t)(u.pm * 256 + t_) * 2 + u.pn] = (part[t_] + part[256 + t_]) + (part[512 + t_] + part[768 + t_]); }
        asm volatile("s_waitcnt lgkmcnt(0)" ::: "memory"); __builtin_amdgcn_s_barrier(); asm volatile("" ::: "memory");
    }
};

__device__ __forceinline__ float wave_sum(float v) {
#pragma unroll
    for (int o = 1; o < 64; o <<= 1) v += __shfl_xor(v, o);
    return v;
}
__device__ __forceinline__ void tr_item(const float* W, int ldw, int srccol0, const float* gain, bf16_t* WT, int K, int drow0, int k0, LAS float* scr, int lane) {
    { const int r8 = lane >> 3, c4 = (lane & 7) * 4;
#pragma unroll
      for (int i = 0; i < 8; ++i) { const int kk = 8 * i + r8; f32x4 v = *(const f32x4*)(W + (size_t)(k0 + kk) * ldw + srccol0 + c4); if (gain) v *= gain[k0 + kk];
          scr[kk * 33 + c4] = v[0]; scr[kk * 33 + c4 + 1] = v[1]; scr[kk * 33 + c4 + 2] = v[2]; scr[kk * 33 + c4 + 3] = v[3]; } }
    asm volatile("s_waitcnt lgkmcnt(0)" ::: "memory");
    const int c = lane & 7;
#pragma unroll
    for (int j = 0; j < 4; ++j) { const int n = (lane >> 3) + 8 * j; const LAS float* s = scr + (8 * c) * 33 + n;
        u32x4 o; o.x = cvt_pk_bf16(s[0 * 33], s[1 * 33]); o.y = cvt_pk_bf16(s[2 * 33], s[3 * 33]); o.z = cvt_pk_bf16(s[4 * 33], s[5 * 33]); o.w = cvt_pk_bf16(s[6 * 33], s[7 * 33]);
        *(u32x4*)(WT + (size_t)(drow0 + n) * K + k0 + 8 * c) = o; }
    asm volatile("s_waitcnt lgkmcnt(0)" ::: "memory");
}
__device__ __forceinline__ void convert_layer_weights(LAS unsigned char* lds, KP P, int L, int first, int stride, int wave, int lane) {
    unsigned char* ws = P->ws;
    LAS float* scr = (LAS float*)(lds + wave * 16384);
    constexpr int I_IN = 16 * 88, I_OUT = 16 * 32, I_GU = 16 * 176, I_DN = 44 * 32, I_GLU = 4 * 16, I_L = I_IN + I_OUT + I_GU + I_DN + I_GLU;
    unsigned char* wl = ws + WS_W + (size_t)L * WL_STRIDE;
    for (int it = first; it < I_L; it += stride) {
        int r = it;
        if (r < I_IN) { const int kb = r / 88, d = (r % 88) * 32; int sc0 = d;
            if (d < 1024) { const int pn = d >> 8, pc = d & 255, wcc = (pc >> 5) & 3, bj = pc >> 7; sc0 = 256 * pn + 128 * (wcc >> 1) + 64 * bj + 32 * (wcc & 1); }
            tr_item(P->in[7] + (size_t)L * DM * DIN, DIN, sc0, P->in[6] + L * DM, (bf16_t*)(wl + WL_IN), DM, d, 64 * kb, scr, lane); continue; }
        r -= I_IN;
        if (r < I_OUT) { const int kb = r / 32, d = (r % 32) * 32;
            tr_item(P->in[9] + (size_t)L * DM * DM, DM, d, P->in[8] + L * DM, (bf16_t*)(wl + WL_OUT), DM, d, 64 * kb, scr, lane); continue; }
        r -= I_OUT;
        if (r < I_GU) { const int kb = r / 176, d = (r % 176) * 32; const int pn = d >> 8, pc = d & 255, bj = pc >> 7; const int ch0 = 128 * pn + (pc & 127);
            tr_item((bj ? P->in[28] : P->in[27]) + (size_t)L * DM * DFF, DFF, ch0, P->in[26] + L * DM, (bf16_t*)(wl + WL_GU), DM, d, 64 * kb, scr, lane); continue; }
        r -= I_GU;
        if (r < I_DN) { const int kb = r / 32, d = (r % 32) * 32;
            tr_item(P->in[29] + (size_t)L * DFF * DM, DM, d, nullptr, (bf16_t*)(wl + WL_DN), DFF, d, 64 * kb, scr, lane); continue; }
        r -= I_DN;
        { const int kb = r / 16, d = (r % 16) * 32; const int pn = d >> 8, pc = d & 255, bj = pc >> 7; const int sc0 = 256 * bj + 128 * pn + (pc & 127);
            tr_item(P->in[18] + (size_t)L * 256 * 512, 512, sc0, nullptr, (bf16_t*)(wl + WL_GLU), 256, d, 64 * kb, scr, lane); }
    }
}
__device__ __forceinline__ void prologue(LAS unsigned char* lds, KP P) {
    const int tid = opaque_tid(), lane = tid & 63, wave = __builtin_amdgcn_readfirstlane(tid >> 6);
    const int G = gridDim.x, gw = blockIdx.x * 8 + wave, NGW = G * 8;
    const int gt = blockIdx.x * 512 + tid, NGT = G * 512;
    unsigned char* ws = P->ws;
    convert_layer_weights(lds, P, 0, gw, NGW, wave, lane);
    { bf16_t* o = (bf16_t*)(ws + WS_LRUW);
      for (int e = gt; e < DEPTH * 4 * 128 * 64; e += NGT) { const int L = e >> 15, hb = (e >> 13) & 3, n = (e >> 6) & 127, i = e & 63;
          const float* src = (n < 64) ? P->in[21] : P->in[23]; o[e] = f2bf(src[(((size_t)L * 4 + hb) * 64 + i) * 64 + (n & 63)]); } }
    for (int e = gt; e < DEPTH * 16 * 64; e += NGT) {
        const int L = e >> 10, g = (e >> 6) & 15, p = e & 63;
        const float are = P->in[10][e], aim = P->in[11][e];
        const float dt = __expf(P->in[17][L * 16 + g]);
        const float mag = expf(are * dt); float ang = aim * dt; const float rev = ang * 0.15915494309189535f; ang = (rev - rintf(rev)) * 6.283185307179586f;
        const float lr = mag * cosf(ang), li = mag * sinf(ang);
        ((f32x2*)(ws + WS_LAMB))[e] = (f32x2){lr, li};
        const float nr = lr - 1.f, ni = li, den = 1.f / (are * are + aim * aim);
        const float cr = (nr * are + ni * aim) * den, ci = (ni * are - nr * aim) * den;
        bf16_t* bb = (bf16_t*)(ws + WS_BB) + ((size_t)(L * 16 + g) * 128) * 32;
        const float* bre = P->in[12] + (size_t)e * 16; const float* bim = P->in[13] + (size_t)e * 16;
        for (int j = 0; j < 16; ++j) { const float br = bre[j], bi = bim[j]; bb[p * 32 + j] = f2bf(cr * br - ci * bi); bb[(64 + p) * 32 + j] = f2bf(cr * bi + ci * br); bb[p * 32 + 16 + j] = 0; bb[(64 + p) * 32 + 16 + j] = 0; }
        bf16_t* cp = (bf16_t*)(ws + WS_CP) + ((size_t)(L * 16 + g) * 16) * 128;
        const float* cre = P->in[14] + ((size_t)(L * 16 + g) * 16) * 64; const float* cim = P->in[15] + ((size_t)(L * 16 + g) * 16) * 64;
        for (int c = 0; c < 16; ++c) { cp[c * 128 + p] = f2bf(cre[c * 64 + p]); cp[c * 128 + 64 + p] = f2bf(-cim[c * 64 + p]); }
    }
    for (int e = gt; e < 2048 * 64; e += NGT) { const int pos = e >> 6, idx = e & 63;
        const float inv = exp2f(-(float)idx * (13.287712379549449f / 64.f)); const float ang = (float)pos * inv;
        const double rev = (double)ang * 0.15915494309189535; const float fr_ = (float)(rev - rint(rev)) * 6.283185307179586f;
        ((f32x2*)(ws + WS_ROT))[e] = (f32x2){cosf(fr_), sinf(fr_)}; }
    { bf16_t* XB = (bf16_t*)(ws + WS_XB); f32x4* sq0 = (f32x4*)(ws + WS_SQMIX);
      for (int m = gw; m < MTOT; m += NGW) {
          const float* xr = (m < MP) ? P->in[0] + (size_t)m * DM : P->in[1] + (size_t)(m - MP) * DM;
          float s = 0.f;
#pragma unroll
          for (int j = 0; j < 4; ++j) { const f32x4 v = ((const f32x4*)xr)[lane + 64 * j]; s += (v[0] * v[0] + v[1] * v[1]) + (v[2] * v[2] + v[3] * v[3]);
              u32x2 w; w.x = cvt_pk_bf16(v[0], v[1]); w.y = cvt_pk_bf16(v[2], v[3]); ((u32x2*)(XB + (size_t)m * DM))[lane + 64 * j] = w; }
          s = wave_sum(s); if (lane == 0) sq0[m] = (f32x4){s, 0.f, 0.f, 0.f}; } }
}

constexpr int R_QS = 0, R_KS = 17408, R_KT = 34816, R_VT = 53248, R_PS = 71680, R_ST = 80896, R_RED = 115712, R_RED2 = 116736;
__device__ __forceinline__ void ret_stage_kv(LAS unsigned char* lds, const u32x4 (&gk)[2], const u32x4 (&gv)[2], int lj, int lc, float kd) {
#pragma unroll
    for (int i = 0; i < 2; ++i) {
        const int c8 = lc + 8 * i;
#pragma unroll
        for (int x = 0; x < 4; ++x) {
            const unsigned kw = gk[i][x], vw = gv[i][x];
            const unsigned kp = cvt_pk_bf16(bflo(kw) * kd, bfhi(kw) * kd);
            *(LAS bf16_t*)(lds + R_KT + (8 * c8 + 2 * x) * 144 + lj * 2) = (bf16_t)(kp & 0xffffu);
            *(LAS bf16_t*)(lds + R_KT + (8 * c8 + 2 * x + 1) * 144 + lj * 2) = (bf16_t)(kp >> 16);
            *(LAS bf16_t*)(lds + R_VT + (8 * c8 + 2 * x) * 144 + lj * 2) = (bf16_t)(vw & 0xffffu);
            *(LAS bf16_t*)(lds + R_VT + (8 * c8 + 2 * x + 1) * 144 + lj * 2) = (bf16_t)(vw >> 16);
        }
    }
}
__device__ __forceinline__ void ret_state_update(LAS unsigned char* lds, f32x4 (&S)[8], int wid, int fr, int fq, float g64) {
    bf16x8 kf[2];
#pragma unroll
    for (int ks = 0; ks < 2; ++ks) kf[ks] = *(const LAS bf16x8*)(lds + R_KT + (16 * wid + fr) * 144 + (32 * ks + 8 * fq) * 2);
#pragma unroll
    for (int tv = 0; tv < 8; ++tv) { S[tv] *= g64;
#pragma unroll
        for (int ks = 0; ks < 2; ++ks) { const bf16x8 vf = *(const LAS bf16x8*)(lds + R_VT + (16 * tv + fr) * 144 + (32 * ks + 8 * fq) * 2); S[tv] = mfma16(kf[ks], vf, S[tv]); } }
}
constexpr int RSEG_N = 6;
__device__ __forceinline__ int rseg_start(int seg) { return seg < 2 ? 6 * seg : 12 + 5 * (seg - 2); }
__device__ __forceinline__ int rseg_len(int seg) { return seg < 2 ? 6 : 5; }
__device__ __forceinline__ void ret_pass1(LAS unsigned char* lds, KP P, int L, int s, int h, int seg) {
    const int tid = opaque_tid(), wid = __builtin_amdgcn_readfirstlane(tid >> 6), lane = tid & 63, fr = lane & 15, fq = lane >> 4;
    const int R0 = s * 2048 + 64 * rseg_start(seg), nch1 = rseg_len(seg);
    const float log2g = log2f(1.f - exp2f(-5.f - (float)h));
    const bf16_t* PROJ = (const bf16_t*)(P->ws + WS_PROJ);
    f32x4 S[8];
#pragma unroll
    for (int tv = 0; tv < 8; ++tv) S[tv] = (f32x4){0.f, 0.f, 0.f, 0.f};
    const int lj = tid & 63, lc = tid >> 6;
    u32x4 gk[2], gv[2];
    { const bf16_t* rp = PROJ + (size_t)(R0 + lj) * DIN + 128 * h + 8 * lc;
#pragma unroll
      for (int i = 0; i < 2; ++i) { gk[i] = *(const u32x4*)(rp + 512 + 64 * i); gv[i] = *(const u32x4*)(rp + 1024 + 64 * i); } }
    const float g64 = exp2f(log2g * 64.f), kd = exp2f(log2g * (float)(63 - lj));
    for (int c = 0; c < nch1; ++c) {
        __syncthreads();
        ret_stage_kv(lds, gk, gv, lj, lc, kd);
        __syncthreads();
        if (c + 1 < nch1) { const bf16_t* rp = PROJ + (size_t)(R0 + 64 * (c + 1) + lj) * DIN + 128 * h + 8 * lc;
#pragma unroll
            for (int i = 0; i < 2; ++i) { gk[i] = *(const u32x4*)(rp + 512 + 64 * i); gv[i] = *(const u32x4*)(rp + 1024 + 64 * i); } }
        ret_state_update(lds, S, wid, fr, fq, g64);
    }
    float* U = (float*)((unsigned char*)P->out + OUT_U) + (size_t)((s * 4 + h) * 8 + seg) * 16384;
#pragma unroll
    for (int tv = 0; tv < 8; ++tv)
#pragma unroll
        for (int jj = 0; jj < 4; ++jj) U[(tv * 4 + jj) * 512 + tid] = S[tv][jj];
}
__device__ __forceinline__ void ret_item(LAS unsigned char* lds, KP P, int L, int s, int h, int seg) {
    const int tid = opaque_tid(), wid = __builtin_amdgcn_readfirstlane(tid >> 6), lane = tid & 63, fr = lane & 15, fq = lane >> 4;
    const bool prompt = s < 16;
    const int R0 = prompt ? s * 2048 + 64 * rseg_start(seg) : MP + (s - 16) * 64, nch = prompt ? rseg_len(seg) : 1;
    const float log2g = log2f(1.f - exp2f(-5.f - (float)h));
    const bf16_t* PROJ = (const bf16_t*)(P->ws + WS_PROJ);
    bf16_t* MIXED = (bf16_t*)(P->ws + WS_MIXED);
    float* gA = (float*)(P->ws + WS_GA);
    f32x4 S[8];
#pragma unroll
    for (int tv = 0; tv < 8; ++tv) S[tv] = (f32x4){0.f, 0.f, 0.f, 0.f};
    if (prompt) {
        const float* U = (const float*)((unsigned char*)P->out + OUT_U) + (size_t)((s * 4 + h) * 8) * 16384 + tid;
        float un[32];
        if (seg > 0) {
#pragma unroll
            for (int e = 0; e < 32; ++e) un[e] = U[e * 512];
        }
        for (int w = 0; w < seg; ++w) {
            const float pw = exp2f(log2g * 64.f * (float)(rseg_start(seg) - rseg_start(w + 1)));
            float uc[32];
#pragma unroll
            for (int e = 0; e < 32; ++e) uc[e] = un[e];
            if (w + 1 < seg) {
#pragma unroll
                for (int e = 0; e < 32; ++e) un[e] = U[(size_t)(w + 1) * 16384 + e * 512];
            }
#pragma unroll
            for (int tv = 0; tv < 8; ++tv)
#pragma unroll
                for (int jj = 0; jj < 4; ++jj) S[tv][jj] += pw * uc[tv * 4 + jj];
        }
    } else {
        const float* sp = P->in[2] + ((size_t)(L * 32 + (s - 16)) * 4 + h) * 16384;
#pragma unroll
        for (int tv = 0; tv < 8; ++tv)
#pragma unroll
            for (int jj = 0; jj < 4; ++jj) S[tv][jj] = sp[(16 * wid + 4 * fq + jj) * 128 + 16 * tv + fr];
    }
    const int lj = tid & 63, lc = tid >> 6;
    u32x4 gq[2], gk[2], gv[2];
    { const bf16_t* rp = PROJ + (size_t)(R0 + lj) * DIN + 128 * h + 8 * lc;
#pragma unroll
      for (int i = 0; i < 2; ++i) { gq[i] = *(const u32x4*)(rp + 64 * i); gk[i] = *(const u32x4*)(rp + 512 + 64 * i); gv[i] = *(const u32x4*)(rp + 1024 + 64 * i); } }
    const float g64 = exp2f(log2g * 64.f), kd = exp2f(log2g * (float)(63 - lj));
    for (int c = 0; c < nch; ++c) {
        __syncthreads();
        {
#pragma unroll
            for (int i = 0; i < 2; ++i) {
                const int c8 = lc + 8 * i;
                *(LAS u32x4*)(lds + R_QS + lj * 272 + c8 * 16) = gq[i];
                *(LAS u32x4*)(lds + R_KS + lj * 272 + c8 * 16) = gk[i];
            }
            ret_stage_kv(lds, gk, gv, lj, lc, kd);
#pragma unroll
            for (int tv = 0; tv < 8; ++tv) { u32x2 w; w.x = cvt_pk_bf16(S[tv][0], S[tv][1]); w.y = cvt_pk_bf16(S[tv][2], S[tv][3]);
                *(LAS u32x2*)(lds + R_ST + (16 * tv + fr) * 272 + (16 * wid + 4 * fq) * 2) = w; }
        }
        __syncthreads();
        if (c + 1 < nch) { const bf16_t* rp = PROJ + (size_t)(R0 + 64 * (c + 1) + lj) * DIN + 128 * h + 8 * lc;
#pragma unroll
            for (int i = 0; i < 2; ++i) { gq[i] = *(const u32x4*)(rp + 64 * i); gk[i] = *(const u32x4*)(rp + 512 + 64 * i); gv[i] = *(const u32x4*)(rp + 1024 + 64 * i); } }
        const int ti = wid >> 1;
        {
            const int tj0 = 2 * (wid & 1);
            f32x4 sc[2] = {(f32x4){0.f, 0.f, 0.f, 0.f}, (f32x4){0.f, 0.f, 0.f, 0.f}};
#pragma unroll
            for (int ks = 0; ks < 4; ++ks) { const bf16x8 qf = *(const LAS bf16x8*)(lds + R_QS + (16 * ti + fr) * 272 + (32 * ks + 8 * fq) * 2);
#pragma unroll
                for (int t2 = 0; t2 < 2; ++t2) { const bf16x8 kf = *(const LAS bf16x8*)(lds + R_KS + (16 * (tj0 + t2) + fr) * 272 + (32 * ks + 8 * fq) * 2); sc[t2] = mfma16(kf, qf, sc[t2]); } }
#pragma unroll
            for (int t2 = 0; t2 < 2; ++t2) { const int i_ = 16 * ti + fr, j0 = 16 * (tj0 + t2) + 4 * fq; float pv[4];
#pragma unroll
                for (int jj = 0; jj < 4; ++jj) pv[jj] = sc[t2][jj] * exp2f(log2g * fabsf((float)(i_ - (j0 + jj))));
                u32x2 w; w.x = cvt_pk_bf16(pv[0], pv[1]); w.y = cvt_pk_bf16(pv[2], pv[3]);
                *(LAS u32x2*)(lds + R_PS + i_ * 144 + j0 * 2) = w; }
        }
        ret_state_update(lds, S, wid, fr, fq, g64);
        __syncthreads();
        const int vh = wid & 1;
        const int irow = 16 * ti + fr, grow = R0 + 64 * c + irow;
        u32x2 gg[4];
#pragma unroll
        for (int t4 = 0; t4 < 4; ++t4) gg[t4] = *(const u32x2*)(PROJ + (size_t)grow * DIN + 1536 + 128 * h + 16 * (4 * vh + t4) + 4 * fq);
        f32x4 oi[4], oc[4];
#pragma unroll
        for (int t4 = 0; t4 < 4; ++t4) { oi[t4] = (f32x4){0.f, 0.f, 0.f, 0.f}; oc[t4] = (f32x4){0.f, 0.f, 0.f, 0.f}; }
#pragma unroll
        for (int ks = 0; ks < 2; ++ks) { const bf16x8 pf = *(const LAS bf16x8*)(lds + R_PS + (16 * ti + fr) * 144 + (32 * ks + 8 * fq) * 2);
#pragma unroll
            for (int t4 = 0; t4 < 4; ++t4) { const bf16x8 vf = *(const LAS bf16x8*)(lds + R_VT + (16 * (4 * vh + t4) + fr) * 144 + (32 * ks + 8 * fq) * 2); oi[t4] = mfma16(vf, pf, oi[t4]); } }
#pragma unroll
        for (int ks = 0; ks < 4; ++ks) { const bf16x8 qf = *(const LAS bf16x8*)(lds + R_QS + (16 * ti + fr) * 272 + (32 * ks + 8 * fq) * 2);
#pragma unroll
            for (int t4 = 0; t4 < 4; ++t4) { const bf16x8 sf = *(const LAS bf16x8*)(lds + R_ST + (16 * (4 * vh + t4) + fr) * 272 + (32 * ks + 8 * fq) * 2); oc[t4] = mfma16(sf, qf, oc[t4]); } }
        const float qd = exp2f(log2g * (float)(irow + 1));
        float s1 = 0.f, s2 = 0.f;
#pragma unroll
        for (int t4 = 0; t4 < 4; ++t4) { oi[t4] = oi[t4] + oc[t4] * qd;
#pragma unroll
            for (int jj = 0; jj < 4; ++jj) { s1 += oi[t4][jj]; s2 += oi[t4][jj] * oi[t4][jj]; } }
        s1 += __shfl_xor(s1, 16); s1 += __shfl_xor(s1, 32); s2 += __shfl_xor(s2, 16); s2 += __shfl_xor(s2, 32);
        LAS f32x2* red = (LAS f32x2*)(lds + R_RED);
        if (fq == 0) red[irow * 2 + vh] = (f32x2){s1, s2};
        __syncthreads();
        const f32x2 ra = red[irow * 2], rb2 = red[irow * 2 + 1];
        const float mean = (ra[0] + rb2[0]) * (1.f / 128.f);
        const float var = (ra[1] + rb2[1]) * (1.f / 128.f) - mean * mean;
        const float rstd = rsqrtf(fmaxf(var, 0.f) + 1e-5f);
        float ss = 0.f;
#pragma unroll
        for (int t4 = 0; t4 < 4; ++t4) {
            const float g0 = bflo(gg[t4][0]), g1 = bfhi(gg[t4][0]), g2 = bflo(gg[t4][1]), g3 = bfhi(gg[t4][1]);
            const float y0 = (oi[t4][0] - mean) * rstd * siluf_(g0), y1 = (oi[t4][1] - mean) * rstd * siluf_(g1);
            const float y2 = (oi[t4][2] - mean) * rstd * siluf_(g2), y3 = (oi[t4][3] - mean) * rstd * siluf_(g3);
            ss += (y0 * y0 + y1 * y1) + (y2 * y2 + y3 * y3);
            u32x2 w; w.x = cvt_pk_bf16(y0, y1); w.y = cvt_pk_bf16(y2, y3);
            *(u32x2*)(MIXED + (size_t)grow * DM + 128 * h + 16 * (4 * vh + t4) + 4 * fq) = w;
        }
        ss += __shfl_xor(ss, 16); ss += __shfl_xor(ss, 32);
        LAS float* red2 = (LAS float*)(lds + R_RED2);
        if (fq == 0) red2[irow * 2 + vh] = ss;
        __syncthreads();
        if (tid < 64) gA[(size_t)(R0 + 64 * c + tid) * 4 + h] = red2[tid * 2] + red2[tid * 2 + 1];
    }
    if (!prompt || seg == RSEG_N - 1) { float* so = P->out + (prompt ? O_PRET + ((size_t)(L * 16 + s) * 4 + h) * 16384 : O_SRET + ((size_t)(L * 32 + (s - 16)) * 4 + h) * 16384);
#pragma unroll
      for (int tv = 0; tv < 8; ++tv)
#pragma unroll
          for (int jj = 0; jj < 4; ++jj) so[(16 * wid + 4 * fq + jj) * 128 + 16 * tv + fr] = S[tv][jj]; }
}

__device__ __forceinline__ void s5_chain(LAS unsigned char* hs  , KP P, int L, int s, int g, int lane, int sc0, int sc1, LAS f32x2* st) {
    if (sc0 >= sc1) return;
    const int fr = lane & 15, fq = lane >> 4;
    const bool prompt = s < 16;
    const int R0 = prompt ? s * 2048 : MP + (s - 16) * 64, nsub = prompt ? 128 : 4;
    const bf16_t* PROJ = (const bf16_t*)(P->ws + WS_PROJ);
    bf16_t* Yb = (bf16_t*)(P->ws + WS_Y);
    const bf16_t* Bb = (const bf16_t*)(P->ws + WS_BB) + ((size_t)(L * 16 + g) * 128) * 32;
    const bf16_t* Cp = (const bf16_t*)(P->ws + WS_CP) + ((size_t)(L * 16 + g) * 16) * 128;
    bf16x8 bfr[8], cfr[4];
#pragma unroll
    for (int nt = 0; nt < 8; ++nt) bfr[nt] = *(const bf16x8*)(Bb + (16 * nt + fr) * 32 + 8 * fq);
#pragma unroll
    for (int ks = 0; ks < 4; ++ks) cfr[ks] = *(const bf16x8*)(Cp + fr * 128 + 32 * ks + 8 * fq);
    float lre[4], lim[4], hre[4], him[4], dsk[4];
#pragma unroll
    for (int n = 0; n < 4; ++n) { const f32x2 l2 = ((const f32x2*)(P->ws + WS_LAMB))[(L * 16 + g) * 64 + 16 * n + fr]; lre[n] = l2[0]; lim[n] = l2[1]; hre[n] = 0.f; him[n] = 0.f; }
    if (!prompt) {
#pragma unroll
        for (int n = 0; n < 4; ++n) { const float* sp = P->in[3] + (((size_t)(L * 32 + (s - 16)) * 16 + g) * 64 + 16 * n + fr) * 2; hre[n] = sp[0]; him[n] = sp[1]; }
    } else if (sc0 > 0) {
#pragma unroll
        for (int n = 0; n < 4; ++n) { const f32x2 e = st[16 * n + fr]; hre[n] = e[0]; him[n] = e[1]; }
    }
#pragma unroll
    for (int jj = 0; jj < 4; ++jj) dsk[jj] = P->in[16][L * 256 + 16 * g + 4 * fq + jj];
    float pwr[4][4], pwi[4][4];
#pragma unroll
    for (int n = 0; n < 4; ++n) { pwr[n][0] = lre[n]; pwi[n][0] = lim[n];
#pragma unroll
        for (int jj = 1; jj < 4; ++jj) { pwr[n][jj] = pwr[n][jj - 1] * lre[n] - pwi[n][jj - 1] * lim[n]; pwi[n][jj] = pwr[n][jj - 1] * lim[n] + pwi[n][jj - 1] * lre[n]; } }
    const bf16_t* up0 = PROJ + (size_t)(R0 + fr) * DIN + 2048 + 16 * g;
    bf16x8 uf_n = (bf16x8){0, 0, 0, 0, 0, 0, 0, 0};
    if (fq < 2) uf_n = *(const bf16x8*)(up0 + (size_t)(16 * sc0) * DIN + 8 * fq);
    u32x2 u4_n = *(const u32x2*)(up0 + (size_t)(16 * sc0) * DIN + 4 * fq);
    for (int sc = sc0; sc < sc1; ++sc) {
        const int r0 = R0 + 16 * sc;
        const bf16x8 uf = uf_n; const u32x2 u4 = u4_n;
        if (sc + 1 < sc1) { const bf16_t* up = up0 + (size_t)(16 * (sc + 1)) * DIN; if (fq < 2) uf_n = *(const bf16x8*)(up + 8 * fq); u4_n = *(const u32x2*)(up + 4 * fq); }
        f32x4 bu[8];
#pragma unroll
        for (int nt = 0; nt < 8; ++nt) bu[nt] = mfma16(uf, bfr[nt], (f32x4){0.f, 0.f, 0.f, 0.f});
#pragma unroll
        for (int n = 0; n < 4; ++n) {
            float Lr[4], Li[4];
            Lr[0] = bu[n][0]; Li[0] = bu[n + 4][0];
#pragma unroll
            for (int jj = 1; jj < 4; ++jj) { Lr[jj] = lre[n] * Lr[jj - 1] - lim[n] * Li[jj - 1] + bu[n][jj]; Li[jj] = lre[n] * Li[jj - 1] + lim[n] * Lr[jj - 1] + bu[n + 4][jj]; }
            float Er[4], Ei[4];
#pragma unroll
            for (int k = 0; k < 4; ++k) { Er[k] = __shfl(Lr[3], 16 * k + fr); Ei[k] = __shfl(Li[3], 16 * k + fr); }
            float hr_ = hre[n], hi_ = him[n], myr = hr_, myi = hi_;
#pragma unroll
            for (int k = 0; k < 4; ++k) { const float nr = pwr[n][3] * hr_ - pwi[n][3] * hi_ + Er[k], ni = pwr[n][3] * hi_ + pwi[n][3] * hr_ + Ei[k]; hr_ = nr; hi_ = ni; if (fq == k + 1) { myr = hr_; myi = hi_; } }
            hre[n] = hr_; him[n] = hi_;
#pragma unroll
            for (int jj = 0; jj < 4; ++jj) { const float cr = Lr[jj] + (pwr[n][jj] * myr - pwi[n][jj] * myi), ci = Li[jj] + (pwr[n][jj] * myi + pwi[n][jj] * myr);
                const unsigned pk = cvt_pk_bf16(cr, ci);
                *(LAS bf16_t*)(hs + (4 * fq + jj) * 272 + (16 * n + fr) * 2) = (bf16_t)pk; *(LAS bf16_t*)(hs + (4 * fq + jj) * 272 + (64 + 16 * n + fr) * 2) = (bf16_t)(pk >> 16); }
        }
        asm volatile("s_waitcnt lgkmcnt(0)" ::: "memory");
        f32x4 y = (f32x4){0.f, 0.f, 0.f, 0.f};
#pragma unroll
        for (int ks = 0; ks < 4; ++ks) { const bf16x8 hf = *(const LAS bf16x8*)(hs + fr * 272 + (32 * ks + 8 * fq) * 2); y = mfma16(cfr[ks], hf, y); }
        asm volatile("s_waitcnt lgkmcnt(0)" ::: "memory");
        const float u0 = bflo(u4[0]), u1 = bfhi(u4[0]), u2 = bflo(u4[1]), u3 = bfhi(u4[1]);
        u32x2 w; w.x = cvt_pk_bf16(geluf_(y[0] + dsk[0] * u0), geluf_(y[1] + dsk[1] * u1)); w.y = cvt_pk_bf16(geluf_(y[2] + dsk[2] * u2), geluf_(y[3] + dsk[3] * u3));
        *(u32x2*)(Yb + (size_t)(r0 + fr) * 256 + 16 * g + 4 * fq) = w;
    }
    if (sc1 < nsub) {
        if (fq == 0) {
#pragma unroll
            for (int n = 0; n < 4; ++n) st[16 * n + fr] = (f32x2){hre[n], him[n]}; }
    } else if (fq == 0) { float* so = P->out + (prompt ? O_PSSM + ((size_t)(L * 16 + s) * 16 + g) * 128 : O_SSSM + ((size_t)(L * 32 + (s - 16)) * 16 + g) * 128);
#pragma unroll
        for (int n = 0; n < 4; ++n) { so[(16 * n + fr) * 2] = hre[n]; so[(16 * n + fr) * 2 + 1] = him[n]; } }
}

__device__ __forceinline__ void lru_m1(KP P, int L, int s, int hb, int q, int lane, int seg) {
    const int fr = lane & 15, fq = lane >> 4;
    const bool prompt = s < 16;
    const int Rs = prompt ? s * 2048 : MP + (s - 16) * 64, tb = prompt ? 256 * seg : 0, nsub = prompt ? 16 : 4;
    const bf16_t* PROJ = (const bf16_t*)(P->ws + WS_PROJ);
    unsigned* HC = (unsigned*)(P->ws + WS_HLOC);
    const int ch = 64 * hb + 16 * q + fr;
    const bf16_t* WT = (const bf16_t*)(P->ws + WS_LRUW) + ((size_t)(L * 4 + hb) * 128) * 64;
    bf16x8 wf[2][2];
#pragma unroll
    for (int tl = 0; tl < 2; ++tl)
#pragma unroll
        for (int ks = 0; ks < 2; ++ks) wf[tl][ks] = *(const bf16x8*)(WT + (64 * tl + 16 * q + fr) * 64 + 32 * ks + 8 * fq);
    const float* cwp = P->in[19] + (size_t)L * 4 * 256;
    const float* cbp = P->in[20] + L * 256;
    float cwo[4];
#pragma unroll
    for (int w = 0; w < 4; ++w) cwo[w] = cwp[w * 256 + ch];
    const float cbo = cbp[ch], ba = P->in[22][L * 256 + ch], bxb = P->in[24][L * 256 + ch];
    const float lam = P->in[25][L * 256 + ch];
    const float sp = fmaxf(-lam, 0.f) + log1pf(__expf(-fabsf(lam)));
    float hc = 0.f, ac = 1.f;
    const float* cbuf = P->in[5] + (size_t)(L * 32 + (prompt ? 0 : (s - 16))) * 3 * 256;
    u32x4 xa[2][4]; bf16_t xr[7];
    f32x4 cwa[2][4][2], cba[2][2];
#pragma unroll
    for (int ks = 0; ks < 2; ++ks) { const int ci = 64 * hb + 32 * ks + 8 * fq; cba[ks][0] = *(const f32x4*)(cbp + ci); cba[ks][1] = *(const f32x4*)(cbp + ci + 4);
#pragma unroll
        for (int w = 0; w < 4; ++w) { cwa[ks][w][0] = *(const f32x4*)(cwp + w * 256 + ci); cwa[ks][w][1] = *(const f32x4*)(cwp + w * 256 + ci + 4); } }
#define LRU_LOAD(t0_) do { \
        _Pragma("unroll") for (int ks = 0; ks < 2; ++ks) { const int ci = 64 * hb + 32 * ks + 8 * fq; \
            _Pragma("unroll") for (int w = 0; w < 4; ++w) { const int tt = (t0_) + fr + w - 3; \
                if (tt >= 0) xa[ks][w] = *(const u32x4*)(PROJ + (size_t)(Rs + tt) * DIN + 2304 + ci); \
                else if (!prompt) { const f32x4 c0 = *(const f32x4*)(cbuf + (tt + 3) * 256 + ci), c1 = *(const f32x4*)(cbuf + (tt + 3) * 256 + ci + 4); \
                    xa[ks][w] = (u32x4){cvt_pk_bf16(c0[0], c0[1]), cvt_pk_bf16(c0[2], c0[3]), cvt_pk_bf16(c1[0], c1[1]), cvt_pk_bf16(c1[2], c1[3])}; } \
                else xa[ks][w] = (u32x4){0u, 0u, 0u, 0u}; } } \
        _Pragma("unroll") for (int e = 0; e < 7; ++e) { const int tt = (t0_) + 4 * fq - 3 + e; \
            if (tt >= 0) xr[e] = PROJ[(size_t)(Rs + tt) * DIN + 2304 + ch]; \
            else if (!prompt) xr[e] = f2bf(cbuf[(tt + 3) * 256 + ch]); \
            else xr[e] = 0; } } while (0)
    LRU_LOAD(tb);
    for (int sc = 0; sc < nsub; ++sc) {
        const int t0 = tb + 16 * sc, r0 = Rs + t0;
        bf16x8 xf[2];
#pragma unroll
        for (int ks = 0; ks < 2; ++ks) {
            const int ci = 64 * hb + 32 * ks + 8 * fq;
            float xv[8];
            { const f32x4 b0 = cba[ks][0], b1 = cba[ks][1];
#pragma unroll
              for (int x = 0; x < 4; ++x) { xv[x] = b0[x]; xv[4 + x] = b1[x]; } }
#pragma unroll
            for (int w = 0; w < 4; ++w) {
                const f32x4 w0 = cwa[ks][w][0], w1 = cwa[ks][w][1];
                const u32x4 pv = xa[ks][w];
                xv[0] += w0[0] * bflo(pv[0]); xv[1] += w0[1] * bfhi(pv[0]); xv[2] += w0[2] * bflo(pv[1]); xv[3] += w0[3] * bfhi(pv[1]);
                xv[4] += w1[0] * bflo(pv[2]); xv[5] += w1[1] * bfhi(pv[2]); xv[6] += w1[2] * bflo(pv[3]); xv[7] += w1[3] * bfhi(pv[3]);
            }
            u32x4 pk; pk.x = cvt_pk_bf16(xv[0], xv[1]); pk.y = cvt_pk_bf16(xv[2], xv[3]); pk.z = cvt_pk_bf16(xv[4], xv[5]); pk.w = cvt_pk_bf16(xv[6], xv[7]);
            xf[ks] = __builtin_bit_cast(bf16x8, pk);
        }
        float xco[4];
#pragma unroll
        for (int jj = 0; jj < 4; ++jj) xco[jj] = cbo + cwo[0] * bf2f(xr[jj]) + cwo[1] * bf2f(xr[jj + 1]) + cwo[2] * bf2f(xr[jj + 2]) + cwo[3] * bf2f(xr[jj + 3]);
        if (sc + 1 < nsub) LRU_LOAD(t0 + 16);
        f32x4 pre[2];
#pragma unroll
        for (int tl = 0; tl < 2; ++tl) { pre[tl] = mfma16(xf[0], wf[tl][0], (f32x4){0.f, 0.f, 0.f, 0.f}); pre[tl] = mfma16(xf[1], wf[tl][1], pre[tl]); }
        float av[4], bv[4];
#pragma unroll
        for (int jj = 0; jj < 4; ++jj) {
            const float r = sigmoidf_(pre[0][jj] + ba), ig = sigmoidf_(pre[1][jj] + bxb);
            const float la = -8.f * r * sp;
            av[jj] = __expf(la);
            bv[jj] = sqrtf(fmaxf(1.f - av[jj] * av[jj], 0.f)) * ig * xco[jj];
        }
        float hr[4] = {0.f, 0.f, 0.f, 0.f}, ar[4] = {0.f, 0.f, 0.f, 0.f};
#pragma unroll
        for (int r = 0; r < 4; ++r) { float cur = hc, ca = ac;
#pragma unroll
            for (int jj = 0; jj < 4; ++jj) { cur = av[jj] * cur + bv[jj]; ca *= av[jj]; if (fq == r) { hr[jj] = cur; ar[jj] = ca; } }
            hc = __shfl(cur, 16 * r + fr); ac = __shfl(ca, 16 * r + fr); }
#pragma unroll
        for (int jj = 0; jj < 4; ++jj) { const size_t o = (size_t)(r0 + 4 * fq + jj) * 256 + ch; HC[o] = cvt_pk_bf16(hr[jj], ar[jj]); }
    }
#undef LRU_LOAD
    if (fq == 0) ((f32x2*)(P->ws + WS_LSUM))[(size_t)(s * 8 + seg) * 256 + ch] = (f32x2){ac, hc};
}
__device__ __forceinline__ void lru_m2(KP P, int L, int gidx, int lane) {
    const int row0 = 16 * gidx;
    const bool prompt = row0 < MP;
    const int s = prompt ? (row0 >> 11) : 16 + ((row0 - MP) >> 6), t = prompt ? (row0 & 2047) : ((row0 - MP) & 63), seg = prompt ? (t >> 8) : 0, len = prompt ? 2048 : 64;
    const bf16_t* PROJ = (const bf16_t*)(P->ws + WS_PROJ);
    bf16_t* MIXED = (bf16_t*)(P->ws + WS_MIXED);
    const unsigned* HC = (const unsigned*)(P->ws + WS_HLOC);
    float* gC = (float*)(P->ws + WS_GC);
    f32x4 hin = (f32x4){0.f, 0.f, 0.f, 0.f};
    if (!prompt) hin = *(const f32x4*)(P->in[4] + (size_t)(L * 32 + (s - 16)) * 256 + 4 * lane);
    else { const f32x2* SUMS = (const f32x2*)(P->ws + WS_LSUM) + (size_t)(s * 8) * 256 + 4 * lane;
        for (int w = 0; w < seg; ++w) {
#pragma unroll
            for (int i = 0; i < 4; ++i) { const f32x2 ab = SUMS[w * 256 + i]; hin[i] = ab[0] * hin[i] + ab[1]; } } }
    f32x4 hlast = hin;
    for (int r = 0; r < 16; ++r) {
        const int row = row0 + r;
        const u32x4 hc = *(const u32x4*)(HC + (size_t)row * 256 + 4 * lane);
        const u32x2 gt = *(const u32x2*)(PROJ + (size_t)row * DIN + 2560 + 4 * lane);
        f32x4 h; h[0] = bflo(hc[0]) + bfhi(hc[0]) * hin[0]; h[1] = bflo(hc[1]) + bfhi(hc[1]) * hin[1]; h[2] = bflo(hc[2]) + bfhi(hc[2]) * hin[2]; h[3] = bflo(hc[3]) + bfhi(hc[3]) * hin[3];
        const float o0 = h[0] * geluf_(bflo(gt[0])), o1 = h[1] * geluf_(bfhi(gt[0])), o2 = h[2] * geluf_(bflo(gt[1])), o3 = h[3] * geluf_(bfhi(gt[1]));
        u32x2 w; w.x = cvt_pk_bf16(o0, o1); w.y = cvt_pk_bf16(o2, o3);
        *(u32x2*)(MIXED + (size_t)row * DM + 768 + 4 * lane) = w;
        const float ss = wave_sum((o0 * o0 + o1 * o1) + (o2 * o2 + o3 * o3));
        if (lane == 0) gC[row] = ss;
        hlast = h;
    }
    if (t + 16 == len) {
        const int sb = prompt ? s : s - 16, NB = prompt ? 16 : 32;
        *(f32x4*)(P->out + (prompt ? O_PLRU : O_SLRU) + (size_t)(L * NB + sb) * 256 + 4 * lane) = hlast;
#pragma unroll
        for (int tau = 0; tau < 3; ++tau) { const u32x2 xv = *(const u32x2*)(PROJ + (size_t)(row0 + 13 + tau) * DIN + 2304 + 4 * lane);
            *(f32x4*)(P->out + (prompt ? O_PCONV : O_SCONV) + ((size_t)(L * NB + sb) * 3 + tau) * 256 + 4 * lane) = (f32x4){bflo(xv[0]), bfhi(xv[0]), bflo(xv[1]), bfhi(xv[1])}; }
    }
}

constexpr int S5_NS1 = MK_MULTI ? 128 : 72;
__device__ __forceinline__ void mixer1_phase(LAS unsigned char* lds, KP P, int L) {
    const int G = gridDim.x, b = blockIdx.x, NO = G - (G + 3) / 4;
    const int tid_ = opaque_tid(); const int wave = __builtin_amdgcn_readfirstlane(tid_ >> 6), lane = tid_ & 63;
    if ((b & 3) == 0) { const int chain = wave * 64 + (b >> 2); if (wave < 4 && chain < 256) s5_chain(lds + wave * 4352, P, L, chain >> 4, chain & 15, lane, 0, S5_NS1, (LAS f32x2*)(lds + 36864 + wave * 512)); return; }
    const int nb = b - (b >> 2) - 1;
    for (int id = nb; id < 448; id += NO) {
        if (id < 320) ret_pass1(lds, P, L, id / 20, (id % 20) / 5, id % 5);
        else { const int k = id - 320; ret_item(lds, P, L, 16 + (k >> 2), k & 3, 0); }
    }
    __syncthreads();
    for (int id = wave * NO + nb; id < 3072; id += 8 * NO) {
        if (id < 2048) { const int chain = id >> 3; lru_m1(P, L, chain >> 4, (chain >> 2) & 3, chain & 3, lane, id & 7); }
        else if (id < 2560) { const int k = id - 2048; s5_chain(lds + wave * 4352, P, L, 16 + (k >> 4), k & 15, lane, 0, 4, nullptr); }
        else { const int k = id - 2560; lru_m1(P, L, 16 + (k >> 4), (k >> 2) & 3, k & 3, lane, 0); }
    }
}
__device__ __forceinline__ void mixer2_phase(LAS unsigned char* lds, KP P, int L) {
    const int G = gridDim.x, b = blockIdx.x, NO = G - (G + 3) / 4;
    const int tid_ = opaque_tid(); const int wave = __builtin_amdgcn_readfirstlane(tid_ >> 6), lane = tid_ & 63;
    if ((b & 3) == 0) { const int chain = wave * 64 + (b >> 2); if (wave < 4 && chain < 256) s5_chain(lds + wave * 4352, P, L, chain >> 4, chain & 15, lane, S5_NS1, 128, (LAS f32x2*)(lds + 36864 + wave * 512)); return; }
    const int nb = b - (b >> 2) - 1;
    for (int id = nb; id < 64 * RSEG_N; id += NO) ret_item(lds, P, L, id / 24, (id % 24) / 6, id % 6);
    for (int id = wave * NO + nb; id < 2176; id += 8 * NO) lru_m2(P, L, id, lane);
}
__device__ __forceinline__ void final_phase(KP P) {
    const int tid_ = opaque_tid(); const int lane = tid_ & 63, wave = __builtin_amdgcn_readfirstlane(tid_ >> 6);
    const int gw = blockIdx.x * 8 + wave, NGW = gridDim.x * 8;
    const f32x4* sq = (const f32x4*)(P->ws + WS_SQMIX);
    f32x4 gn[4];
#pragma unroll
    for (int j = 0; j < 4; ++j) gn[j] = ((const f32x4*)P->in[30])[lane + 64 * j];
    const bf16_t* XB = (const bf16_t*)(P->ws + WS_XB);
    for (int m = gw; m < MTOT; m += NGW) {
        const float rs = rsqrtf(sum4(sq[m]) * (1.f / 1024.f) + 1e-6f);
        const u32x2* xb = (const u32x2*)(XB + (size_t)m * DM);
        f32x4* yr = (f32x4*)(P->out + (size_t)m * DM);
#pragma unroll
        for (int j = 0; j < 4; ++j) { const u32x2 w = xb[lane + 64 * j]; const f32x4 v = (f32x4){bflo(w[0]), bfhi(w[0]), bflo(w[1]), bfhi(w[1])}; yr[lane + 64 * j] = v * rs * gn[j]; }
    }
}

__device__ __forceinline__ void combine_phase(KP P) {
    const int tid_ = opaque_tid(); const int lane = tid_ & 63, wave = __builtin_amdgcn_readfirstlane(tid_ >> 6);
    const int gw = blockIdx.x * 8 + wave, NGW = gridDim.x * 8;
    const float* PART = (const float*)P->out; bf16_t* XB = (bf16_t*)(P->ws + WS_XB); float* sqn = (float*)(P->ws + WS_SQMIX);
    for (int it = gw; it < 2048 * 4; it += NGW) {
        const int r = it >> 2, pn = it & 3, row = MP + r;
        const float* p0 = PART + (size_t)((r >> 8) * 4 + pn) * 65536 + (r & 255) * 256 + 4 * lane;
        const f32x4 a = *(const f32x4*)p0 + *(const f32x4*)(p0 + (size_t)32 * 65536);
        u32x2* xp = (u32x2*)(XB + (size_t)row * DM + pn * 256 + 4 * lane);
        const u32x2 xv = *xp;
        const f32x4 xn = (f32x4){bflo(xv[0]), bfhi(xv[0]), bflo(xv[1]), bfhi(xv[1])} + a;
        u32x2 w; w.x = cvt_pk_bf16(xn[0], xn[1]); w.y = cvt_pk_bf16(xn[2], xn[3]); *xp = w;
        const float ss = wave_sum((xn[0] * xn[0] + xn[1] * xn[1]) + (xn[2] * xn[2] + xn[3] * xn[3]));
        if (lane == 0) sqn[(size_t)row * 4 + pn] = ss;
    }
}

#define XB_TMO      128
#define XB_XCNT(j)  (256  + 64 * (j))
#define XB_XSUB(j)  (1280 + 64 * (j))
#define XB_XGEN(j)  (2304 + 64 * (j))
#define XB_TOP      3328
#define XB_TOPGEN   3392
#define XCD_BAR_WORDS 3456
#define XB_SPIN_CAP (1u << 18)

__device__ __forceinline__ unsigned xb_ld(unsigned* p)              { return __hip_atomic_load(p, __ATOMIC_RELAXED, __HIP_MEMORY_SCOPE_AGENT); }
__device__ __forceinline__ unsigned xb_add(unsigned* p, unsigned v) { return __hip_atomic_fetch_add(p, v, __ATOMIC_RELAXED, __HIP_MEMORY_SCOPE_AGENT); }
__device__ __forceinline__ unsigned xb_xcc_id() { return (unsigned)__builtin_amdgcn_s_getreg((3 << 11) | 20) & 0xFu; }
#define XB_SPIN(cond, bar) do { unsigned _sp = 0; while (cond) { __builtin_amdgcn_s_sleep(1); \
    if ((++_sp & 255u) == 0u) { if (xb_ld(&(bar)[XB_TMO])) break; if (_sp > XB_SPIN_CAP) { atomicAdd(&(bar)[XB_TMO], 1u); break; } } } } while (0)

struct XcdBarrier {
    unsigned* bar; unsigned x;
    volatile LAS unsigned* st;
};

__device__ __forceinline__ XcdBarrier xcd_barrier_post(unsigned* bar, volatile LAS unsigned* st) {
    XcdBarrier b; b.bar = bar; b.x = xb_xcc_id(); b.st = st;
    if (threadIdx.x == 0) (void)xb_add(&bar[XB_XCNT(b.x)], 1u);
    return b;
}
__device__ __forceinline__ void xcd_barrier_complete(unsigned* bar, unsigned x, unsigned& nloc, unsigned& nx) {
    const unsigned G = gridDim.x * gridDim.y * gridDim.z;
    unsigned sum, cnt, mine, sp = 0u;
    for (;;) {
        sum = 0u; cnt = 0u; mine = 0u;
#pragma unroll
        for (unsigned j = 0; j < 16; ++j) { const unsigned c = xb_ld(&bar[XB_XCNT(j)]); sum += c; cnt += (c > 0u) ? 1u : 0u; mine = (j == x) ? c : mine; }
        if (sum == G) break;
        __builtin_amdgcn_s_sleep(1);
        if ((++sp & 255u) == 0u) { if (xb_ld(&bar[XB_TMO])) break; if (sp > XB_SPIN_CAP) { atomicAdd(&bar[XB_TMO], 1u); break; } }
    }
    nloc = mine > 0u ? mine : 1u; nx = cnt > 0u ? cnt : 1u;
}

__device__ __forceinline__ void xcd_barrier(const XcdBarrier& b) {
    asm volatile("s_waitcnt vmcnt(0)" ::: "memory");
    __syncthreads();
    if (threadIdx.x == 0) {
        unsigned* bar = b.bar;
        __builtin_amdgcn_s_waitcnt(0);
        unsigned nloc = b.st[0], nx = b.st[1];
        if (nloc == 0u) { xcd_barrier_complete(bar, b.x, nloc, nx); b.st[0] = nloc; b.st[1] = nx; }
        const unsigned old = xb_add(&bar[XB_XSUB(b.x)], 1u);
        const unsigned gen = old / nloc;
        if (old + 1u == (gen + 1u) * nloc) {
            __builtin_amdgcn_fence(__ATOMIC_RELEASE, "agent");
            asm volatile("s_waitcnt vmcnt(0)" ::: "memory");
            const unsigned og = xb_add(&bar[XB_TOP], 1u);
            const unsigned tg = og / nx;
            if (og + 1u == (tg + 1u) * nx) xb_add(&bar[XB_TOPGEN], 1u);
            else XB_SPIN(xb_ld(&bar[XB_TOPGEN]) == tg, bar);
            __builtin_amdgcn_fence(__ATOMIC_ACQUIRE, "agent");
            xb_add(&bar[XB_XGEN(b.x)], 1u);
            asm volatile("s_waitcnt vmcnt(0)" ::: "memory");
        } else {
            XB_SPIN(xb_ld(&bar[XB_XGEN(b.x)]) == gen, bar);
            __builtin_amdgcn_fence(__ATOMIC_ACQUIRE, "agent");
            asm volatile("s_waitcnt vmcnt(0)" ::: "memory");
        }
    }
    __syncthreads();
}


constexpr int LDS_BYTES = 131072 + 4096 + 64;
constexpr size_t WS_CTL = 0, CTL_ZERO_BYTES = 16384;
__global__ void __launch_bounds__(512, 2) mk_fwd(Params Pk) {
    extern __shared__ __attribute__((aligned(16))) unsigned char lds_raw[];
    LAS unsigned char* lds = (LAS unsigned char*)lds_raw;
    const int ph_lo = Pk.ph_lo, ph_hi = Pk.ph_hi;
    const KP pp = (KP)__builtin_amdgcn_kernarg_segment_ptr();
#if !MK_MULTI
    volatile LAS unsigned* bst = (volatile LAS unsigned*)(lds + 131072 + 4096);
    if (threadIdx.x < 2) bst[threadIdx.x] = 0u;
    __syncthreads();
    const XcdBarrier gbar = xcd_barrier_post((unsigned*)(Pk.ws + WS_CTL), bst);
#endif
    for (int ph = ph_lo; ph < ph_hi; ++ph) {
        KP P = pp; asm volatile("" : "+s"(P));
        unsigned char* ws = P->ws; const int G = gridDim.x;
        LAS float* part = (LAS float*)(lds + 131072);
        bf16_t* XB = (bf16_t*)(ws + WS_XB); bf16_t* MIXED = (bf16_t*)(ws + WS_MIXED); bf16_t* Yb = (bf16_t*)(ws + WS_Y); bf16_t* PROJ = (bf16_t*)(ws + WS_PROJ);
        for (int rep_ = 0; rep_ < ((ph > 0 && ph < NPH - 1 && (ph - 1) % NSUB == REP_SUB) ? 2 : 1); ++rep_) {
        if (ph == 0) { prologue(lds, P);
#if PROBE_PRO
            __syncthreads(); prologue(lds, P);
#endif
        }
        else if (ph == NPH - 1) final_phase(P);
        else {
            const int L = (ph - 1) / NSUB, sub = (ph - 1) % NSUB;
            unsigned char* wl = ws + WS_W + (size_t)L * WL_STRIDE;
            pg8::StaticOrder S;
            if (sub == 0) {
                pg8::Gemm g{XB, (const bf16_t*)(wl + WL_IN), MTOT, DIN, DM}; S.init(MTOT, DIN, G, (int)blockIdx.x);
                EpiProj E{PROJ, (const f32x4*)(ws + WS_SQMIX), (const f32x4*)(ws + WS_ROT)};
                pg8::gemm_phase<EpiProj>(lds, g, S, E);
            } else if (sub == 1) {
                mixer1_phase(lds, P, L);
            } else if (sub == 2) {
                mixer2_phase(lds, P, L);
#if PROBE_M12 && !MK_MULTI
                xcd_barrier(gbar); mixer1_phase(lds, P, L); xcd_barrier(gbar); mixer2_phase(lds, P, L);
#endif
            } else if (sub == 3) {
                pg8::Gemm g{Yb, (const bf16_t*)(wl + WL_GLU), MTOT, 512, 256}; S.init(MTOT, 512, G, (int)blockIdx.x);
                EpiGLU E{MIXED, (float*)(ws + WS_GB), part};
                pg8::gemm_phase<EpiGLU>(lds, g, S, E);
            } else if (sub == 4) {
                pg8::Gemm g{MIXED, (const bf16_t*)(wl + WL_OUT), MTOT, DM, DM}; S.init(MTOT, DM, G, (int)blockIdx.x);
                EpiRes<true> E{nullptr, XB, (float*)(ws + WS_SQFFN), (const f32x4*)(ws + WS_GA), (const f32x2*)(ws + WS_GB), (const float*)(ws + WS_GC), part};
                pg8::gemm_phase<EpiRes<true>>(lds, g, S, E);
            } else if (sub == 5) {
                pg8::Gemm g{XB, (const bf16_t*)(wl + WL_GU), MTOT, 2 * DFF, DM}; S.init(MTOT, 2 * DFF, G, (int)blockIdx.x);
                EpiSwiGLU E{PROJ  , (const f32x4*)(ws + WS_SQFFN)};
                pg8::gemm_phase<EpiSwiGLU>(lds, g, S, E);
            } else {
#if MK_MULTI
                pg8::Gemm g{PROJ, (const bf16_t*)(wl + WL_DN), MTOT, DM, DFF}; S.init(MTOT, DM, G, (int)blockIdx.x);
                EpiRes<false> E{nullptr, XB, (float*)(ws + WS_SQMIX), nullptr, nullptr, nullptr, part};
                pg8::gemm_phase<EpiRes<false>>(lds, g, S, E);
#else
                { pg8::Gemm g{PROJ, (const bf16_t*)(wl + WL_DN), MP, DM, DFF}; S.init(MP, DM, G, (int)blockIdx.x);
                  EpiRes<false> E{nullptr, XB, (float*)(ws + WS_SQMIX), nullptr, nullptr, nullptr, part};
                  pg8::gemm_phase<EpiRes<false>>(lds, g, S, E); }
                { pg8::Gemm g{PROJ + (size_t)MP * DFF, (const bf16_t*)(wl + WL_DN), 2048, 2048, DFF / 2, DFF}; S.init(2048, 2048, G, (int)blockIdx.x);
                  EpiPart E{P->out};
                  pg8::gemm_phase<EpiPart>(lds, g, S, E); }
                if (L + 1 < DEPTH && (int)blockIdx.x >= 64 && G > 64) {
                    const int tid_ = opaque_tid(); const int wave = __builtin_amdgcn_readfirstlane(tid_ >> 6), lane = tid_ & 63;
                    convert_layer_weights(lds, P, L + 1, ((int)blockIdx.x - 64) * 8 + wave, (G - 64) * 8, wave, lane);
                }
                xcd_barrier(gbar);
                combine_phase(P);
#endif
            }
        }
        }
#if !MK_MULTI
        if (ph + 1 < ph_hi) {
            if (ph == ph_lo) {
                asm volatile("s_waitcnt vmcnt(0)" ::: "memory"); __syncthreads();
                if (threadIdx.x == 0) { __builtin_amdgcn_fence(__ATOMIC_RELEASE, "agent"); asm volatile("s_waitcnt vmcnt(0)" ::: "memory"); }
                __syncthreads();
                cg::this_grid().sync();
                if (threadIdx.x == 0) { __builtin_amdgcn_fence(__ATOMIC_ACQUIRE, "agent"); asm volatile("s_waitcnt vmcnt(0)" ::: "memory"); }
                __syncthreads();
            } else xcd_barrier(gbar);
        }
#endif
    }
}

extern "C" void kernel_launch(void* const* d_in, const int* in_sizes, int n_in, void* d_out, int out_size, void* d_ws, size_t ws_size, hipStream_t stream) {
    static int grid = 0;
    if (grid == 0) {
        if (n_in != 31 || ws_size < WS_END) { fprintf(stderr, "kernel_launch: expected 31 inputs and >= %zu B of workspace (got %d, %zu)\n", (size_t)WS_END, n_in, ws_size); grid = -1; return; }
        if (hipFuncSetAttribute((const void*)mk_fwd, hipFuncAttributeMaxDynamicSharedMemorySize, LDS_BYTES) != hipSuccess) { fprintf(stderr, "kernel_launch: hipFuncSetAttribute failed\n"); grid = -1; return; }
        int dev = 0, cus = 0, per_cu = 0;
        hipGetDevice(&dev); hipDeviceGetAttribute(&cus, hipDeviceAttributeMultiprocessorCount, dev);
        hipOccupancyMaxActiveBlocksPerMultiprocessor(&per_cu, (const void*)mk_fwd, 512, LDS_BYTES);
        (void)hipGetLastError();
        grid = cus * (per_cu < 1 ? 1 : per_cu);
        if (grid > 256) grid = 256;
        if (grid < 128) { fprintf(stderr, "kernel_launch: grid %d too small for the mixer phase layout\n", grid); grid = -1; return; }
    }
    if (grid < 0) return;
#if !MK_MULTI
    if (hipMemsetAsync((char*)d_ws + WS_CTL, 0, CTL_ZERO_BYTES, stream) != hipSuccess) { fprintf(stderr, "kernel_launch: memset of the barrier words failed\n"); return; }
#endif
    Params p{};
    for (int i = 0; i < 31; ++i) p.in[i] = (const float*)d_in[i];
    p.out = (float*)d_out; p.ws = (unsigned char*)d_ws;
#if MK_MULTI
    for (int ph = 0; ph < NPH; ++ph) { p.ph_lo = ph; p.ph_hi = ph + 1; hipLaunchKernelGGL(mk_fwd, dim3(grid), dim3(512), LDS_BYTES, stream, p); }
#else
    p.ph_lo = 0; p.ph_hi = NPH;
    void* args[] = {&p};
    hipError_t e = hipLaunchCooperativeKernel((const void*)mk_fwd, dim3(grid), dim3(512), args, LDS_BYTES, stream);
    if (e != hipSuccess) fprintf(stderr, "kernel_launch: cooperative launch failed: %s (grid %d)\n", hipGetErrorString(e), grid);
#endif
}
```
